# Optimizing an MI355X kernel written in HIP

```python
import math, functools
import jax, jax.numpy as jnp
from jax import lax
import numpy as np

D_MODEL = 1024
BATCH = 16
SEQ = 2048
DEPTH = 2

CTX_LEN = 256
GRID_W = 64
D_FF = 2816
N_MOD = 9
EPS = 1e-6
ROPE_BASE = 10000.0
Q_BLOCK = 128

MLA_HEADS = 8
MLA_Q_RANK = 256
MLA_KV_RANK = 128
MLA_NOPE = 64
MLA_ROPE = 32
MLA_V = 64

SWA_HEADS = 8
SWA_KV_HEADS = 2
SWA_HEAD_DIM = 64
SWA_WINDOW = 128
SWA_BLOCK = 128

DIFF_HEADS = 8
DIFF_HEAD_DIM = 64

L0_IN_SIZES = (MLA_Q_RANK, MLA_KV_RANK, MLA_ROPE, SWA_HEADS * SWA_HEAD_DIM, SWA_KV_HEADS * SWA_HEAD_DIM, SWA_KV_HEADS * SWA_HEAD_DIM)
L0_IN_WIDTH = sum(L0_IN_SIZES)
L0_OUT_WIDTH = MLA_HEADS * MLA_V + SWA_HEADS * SWA_HEAD_DIM
L1_IN_WIDTH = 3 * DIFF_HEADS * 2 * DIFF_HEAD_DIM
L1_OUT_WIDTH = DIFF_HEADS * 2 * DIFF_HEAD_DIM

kernel_name = "hybrid_diffusion_mla_swa_diffattn_block"


def rms_norm(x, g):
    xf = x.astype(jnp.float32)
    y = xf * lax.rsqrt(jnp.mean(xf * xf, axis=-1, keepdims=True) + EPS)
    return (y * g.astype(jnp.float32)).astype(x.dtype)


def adaln(x, g, mod, k):
    return rms_norm(x, g) * (1 + mod[..., 3 * k + 1, :]) + mod[..., 3 * k, :]


def swiglu(h, wg, wu, wd):
    return (jax.nn.silu(h @ wg) * (h @ wu)) @ wd


def lambda_init_fn(layer_idx):
    return 0.8 - 0.6 * math.exp(-0.3 * layer_idx)


def axial_rope(n_rows, rot_dim):
    t_row = jnp.repeat(jnp.arange(n_rows, dtype=jnp.float32), GRID_W)
    t_col = jnp.broadcast_to(jnp.arange(GRID_W, dtype=jnp.float32)[None, :], (n_rows, GRID_W)).reshape(-1)
    n_f = rot_dim // 4
    inv = ROPE_BASE ** (-jnp.arange(n_f, dtype=jnp.float32) / n_f)
    ang = jnp.concatenate([t_row[:, None] * inv, t_col[:, None] * inv], axis=-1)
    return jnp.cos(ang), jnp.sin(ang)


def apply_rope(x, cos, sin):
    half = x.shape[-1] // 2
    shape = (cos.shape[0],) + (1,) * (x.ndim - 3) + (half,)
    cos, sin = cos.reshape(shape), sin.reshape(shape)
    x1, x2 = x[..., :half], x[..., half:]
    return jnp.concatenate([x1 * cos - x2 * sin, x1 * sin + x2 * cos], axis=-1).astype(x.dtype)


def sweep_query_blocks(fn, q):
    B, S = q.shape[:2]
    nb = S // Q_BLOCK
    qb = jnp.moveaxis(q.reshape((B, nb, Q_BLOCK) + q.shape[2:]), 1, 0)
    out = lax.map(fn, qb)
    return jnp.moveaxis(out, 0, 1).reshape((B, S) + out.shape[3:])


def softmax_attention_block(qb, k, v, scale):
    s = jnp.einsum('bqhd,bkhd->bhqk', qb, k).astype(jnp.float32) * scale
    p = jax.nn.softmax(s, axis=-1).astype(v.dtype)
    return jnp.einsum('bhqk,bkhd->bqhd', p, v)


def mla_queries(p_qa, qa_g, wqb, q_g, rope):
    B, N = p_qa.shape[:2]
    q = (rms_norm(p_qa, qa_g) @ wqb).reshape(B, N, MLA_HEADS, MLA_NOPE + MLA_ROPE)
    q = rms_norm(q, q_g)
    if rope is not None:
        q = jnp.concatenate([q[..., :MLA_NOPE], apply_rope(q[..., MLA_NOPE:], *rope)], axis=-1)
    return q


def mla_keys_values(p_kva, p_kr, kva_g, wkvb, k_g, rope):
    B, N = p_kva.shape[:2]
    kv = (rms_norm(p_kva, kva_g) @ wkvb).reshape(B, N, MLA_HEADS, MLA_NOPE + MLA_V)
    k_rope = jnp.broadcast_to(p_kr[:, :, None, :], (B, N, MLA_HEADS, MLA_ROPE))
    k = rms_norm(jnp.concatenate([kv[..., :MLA_NOPE], k_rope], axis=-1), k_g)
    if rope is not None:
        k = jnp.concatenate([k[..., :MLA_NOPE], apply_rope(k[..., MLA_NOPE:], *rope)], axis=-1)
    return k, kv[..., MLA_NOPE:]


def window_attention_latent(q, k, v, kc, vc, sink, scale):
    B, S, Hq, d = q.shape
    Hkv = k.shape[2]
    G = Hq // Hkv
    W = SWA_BLOCK
    nb = S // W
    L = kc.shape[1]

    def band(t):
        tb = t.reshape(B, nb, W, Hkv, d)
        tp = jnp.pad(tb, ((0, 0), (1, 1), (0, 0), (0, 0), (0, 0)))
        return jnp.moveaxis(jnp.concatenate([tp[:, :-2], tp[:, 1:-1], tp[:, 2:]], axis=2), 1, 0)

    qb = jnp.moveaxis(q.reshape(B, nb, W, Hkv, G, d), 1, 0)
    q_pos = jnp.arange(nb)[:, None] * W + jnp.arange(W)[None, :]
    k_pos = (jnp.arange(nb)[:, None] - 1) * W + jnp.arange(3 * W)[None, :]
    valid = ((jnp.abs(k_pos[:, None, :] - q_pos[:, :, None]) <= SWA_WINDOW)
             & (k_pos[:, None, :] >= 0) & (k_pos[:, None, :] < S))
    sink_logit = sink.reshape(Hkv, G)[None, :, :, None, None].astype(jnp.float32)

    def one_block(args):
        qblk, kblk, vblk, mask = args
        s_loc = jnp.einsum('bqhgd,bkhd->bhgqk', qblk, kblk).astype(jnp.float32) * scale
        s_loc = jnp.where(mask, s_loc, -jnp.inf)
        s_ctx = jnp.einsum('bqhgd,blhd->bhgql', qblk, kc).astype(jnp.float32) * scale
        s_sink = jnp.broadcast_to(sink_logit, s_ctx.shape[:-1] + (1,))
        p = jax.nn.softmax(jnp.concatenate([s_ctx, s_loc, s_sink], axis=-1), axis=-1).astype(v.dtype)
        return (jnp.einsum('bhgql,blhd->bqhgd', p[..., :L], vc)
                + jnp.einsum('bhgqk,bkhd->bqhgd', p[..., L:L + 3 * W], vblk))

    out = lax.map(one_block, (qb, band(k), band(v), valid))
    return jnp.moveaxis(out, 0, 1).reshape(B, S, Hq, d)


def window_attention_context(qc, kc, vc, sink, scale):
    B, L, Hq, d = qc.shape
    Hkv = kc.shape[2]
    G = Hq // Hkv
    qg = qc.reshape(B, L, Hkv, G, d)
    s = jnp.einsum('blhgd,bmhd->bhglm', qg, kc).astype(jnp.float32) * scale
    s_sink = jnp.broadcast_to(sink.reshape(Hkv, G)[None, :, :, None, None].astype(jnp.float32), s.shape[:-1] + (1,))
    p = jax.nn.softmax(jnp.concatenate([s, s_sink], axis=-1), axis=-1)[..., :-1].astype(vc.dtype)
    return jnp.einsum('bhglm,bmhd->blhgd', p, vc).reshape(B, L, Hq, d)


def mixer_mla_swa(h, hc, need_ctx, rope_mla, rope_swa, w_in, mla_qa_g, mla_wqb, mla_kva_g, mla_wkvb,
                  mla_q_g, mla_k_g, swa_q_g, swa_k_g, swa_sink, w_out):
    B, S = h.shape[:2]
    split_at = [int(i) for i in np.cumsum(L0_IN_SIZES)[:-1]]
    qa, kva, kr, sq, sk, sv = jnp.split(h @ w_in, split_at, axis=-1)
    qa_c, kva_c, kr_c, sq_c, sk_c, sv_c = jnp.split(hc @ w_in, split_at, axis=-1)
    mla_scale = (MLA_NOPE + MLA_ROPE) ** -0.5
    swa_scale = SWA_HEAD_DIM ** -0.5

    q = mla_queries(qa, mla_qa_g, mla_wqb, mla_q_g, rope_mla)
    k, v = mla_keys_values(kva, kr, mla_kva_g, mla_wkvb, mla_k_g, rope_mla)
    k_c, v_c = mla_keys_values(kva_c, kr_c, mla_kva_g, mla_wkvb, mla_k_g, None)
    k_all = jnp.concatenate([k_c, k], axis=1)
    v_all = jnp.concatenate([v_c, v], axis=1)
    a = sweep_query_blocks(lambda qb: softmax_attention_block(qb, k_all, v_all, mla_scale), q)

    def swa_heads(p, n_heads, g, rope):
        t = p.reshape(p.shape[0], p.shape[1], n_heads, SWA_HEAD_DIM)
        t = rms_norm(t, g) if g is not None else t
        return apply_rope(t, *rope) if rope is not None else t

    sq_l = swa_heads(sq, SWA_HEADS, swa_q_g, rope_swa)
    sk_l = swa_heads(sk, SWA_KV_HEADS, swa_k_g, rope_swa)
    sv_l = swa_heads(sv, SWA_KV_HEADS, None, None)
    sk_cc = swa_heads(sk_c, SWA_KV_HEADS, swa_k_g, None)
    sv_cc = swa_heads(sv_c, SWA_KV_HEADS, None, None)
    b = window_attention_latent(sq_l, sk_l, sv_l, sk_cc, sv_cc, swa_sink, swa_scale)

    y = jnp.concatenate([a.reshape(B, S, -1), b.reshape(B, S, -1)], axis=-1) @ w_out
    if not need_ctx:
        return y, None
    L = hc.shape[1]
    a_c = softmax_attention_block(mla_queries(qa_c, mla_qa_g, mla_wqb, mla_q_g, None), k_c, v_c, mla_scale)
    b_c = window_attention_context(swa_heads(sq_c, SWA_HEADS, swa_q_g, None), sk_cc, sv_cc, swa_sink, swa_scale)
    y_c = jnp.concatenate([a_c.reshape(B, L, -1), b_c.reshape(B, L, -1)], axis=-1) @ w_out
    return y, y_c


def mixer_diff(h, hc, need_ctx, rope, w_in, q_g, k_g, lambda_q1, lambda_k1, lambda_q2, lambda_k2,
               subln_g, w_out, lambda_init):
    scale = DIFF_HEAD_DIM ** -0.5

    def split_heads(t):
        B, N = t.shape[:2]
        q, k, v = jnp.split(t @ w_in, 3, axis=-1)
        return (q.reshape(B, N, DIFF_HEADS, 2, DIFF_HEAD_DIM),
                k.reshape(B, N, DIFF_HEADS, 2, DIFF_HEAD_DIM),
                v.reshape(B, N, DIFF_HEADS, 2 * DIFF_HEAD_DIM))

    def qk_prep(t, g, rope_t):
        t = rms_norm(t, g)
        return apply_rope(t, *rope_t) if rope_t is not None else t

    lam = (jnp.exp(jnp.sum(lambda_q1.astype(jnp.float32) * lambda_k1.astype(jnp.float32)))
           - jnp.exp(jnp.sum(lambda_q2.astype(jnp.float32) * lambda_k2.astype(jnp.float32)))
           + lambda_init)

    def diff_block(qb, k, v):
        s = jnp.einsum('bqhmd,bkhmd->bhmqk', qb, k).astype(jnp.float32) * scale
        p = jax.nn.softmax(s, axis=-1)
        a = (p[:, :, 0] - lam * p[:, :, 1]).astype(v.dtype)
        return jnp.einsum('bhqk,bkhd->bqhd', a, v)

    def heads_out(o):
        o = rms_norm(o, subln_g) * (1 - lambda_init)
        return o.reshape(o.shape[0], o.shape[1], -1) @ w_out

    q, k, v = split_heads(h)
    q, k = qk_prep(q, q_g, rope), qk_prep(k, k_g, rope)
    q_c, k_c, v_c = split_heads(hc)
    k_c = qk_prep(k_c, k_g, None)
    k_all = jnp.concatenate([k_c, k], axis=1)
    v_all = jnp.concatenate([v_c, v], axis=1)
    y = heads_out(sweep_query_blocks(lambda qb: diff_block(qb, k_all, v_all), q))
    if not need_ctx:
        return y, None
    y_c = heads_out(diff_block(qk_prep(q_c, q_g, None), k_c, v_c))
    return y, y_c


def setup_inputs(seed: int = 0) -> dict:
    key = jax.random.key(seed)
    keys = iter(jax.random.split(key, 48))
    f32 = jnp.float32

    def nrm(shape, s):
        return jax.random.normal(next(keys), shape, f32) * s

    def lin(shape, s=1.0):
        return nrm(shape, s * shape[-2] ** -0.5)

    def gain(shape):
        return 1.0 + nrm(shape, 0.05)

    def common(p):
        return {
            p + "ada_w": lin((D_MODEL, N_MOD * D_MODEL), 0.5),
            p + "ada_b": nrm((N_MOD * D_MODEL,), 0.02),
            p + "norm_g": gain((3, D_MODEL)),
            p + "ffn_wg": lin((2, D_MODEL, D_FF)),
            p + "ffn_wu": lin((2, D_MODEL, D_FF)),
            p + "ffn_wd": lin((2, D_FF, D_MODEL)),
        }

    inputs = {
        "x": nrm((BATCH, SEQ, D_MODEL), 1.0),
        "c": nrm((BATCH, D_MODEL), 1.0),
        "ctx": nrm((BATCH, CTX_LEN, D_MODEL), 1.0),
        "c_ctx": nrm((D_MODEL,), 1.0),
    }
    inputs.update(common("l0_"))
    inputs.update({
        "l0_w_in": lin((D_MODEL, L0_IN_WIDTH)),
        "l0_mla_qa_g": gain((MLA_Q_RANK,)),
        "l0_mla_wqb": lin((MLA_Q_RANK, MLA_HEADS * (MLA_NOPE + MLA_ROPE))),
        "l0_mla_kva_g": gain((MLA_KV_RANK,)),
        "l0_mla_wkvb": lin((MLA_KV_RANK, MLA_HEADS * (MLA_NOPE + MLA_V))),
        "l0_mla_q_g": gain((MLA_NOPE + MLA_ROPE,)),
        "l0_mla_k_g": gain((MLA_NOPE + MLA_ROPE,)),
        "l0_swa_q_g": gain((SWA_HEAD_DIM,)),
        "l0_swa_k_g": gain((SWA_HEAD_DIM,)),
        "l0_swa_sink": nrm((SWA_HEADS,), 1.0),
        "l0_w_out": lin((L0_OUT_WIDTH, D_MODEL)),
    })
    inputs.update(common("l1_"))
    inputs.update({
        "l1_w_in": lin((D_MODEL, L1_IN_WIDTH)),
        "l1_q_g": gain((DIFF_HEAD_DIM,)),
        "l1_k_g": gain((DIFF_HEAD_DIM,)),
        "l1_lambda_q1": nrm((DIFF_HEAD_DIM,), 0.1),
        "l1_lambda_k1": nrm((DIFF_HEAD_DIM,), 0.1),
        "l1_lambda_q2": nrm((DIFF_HEAD_DIM,), 0.1),
        "l1_lambda_k2": nrm((DIFF_HEAD_DIM,), 0.1),
        "l1_subln_g": gain((2 * DIFF_HEAD_DIM,)),
        "l1_w_out": lin((L1_OUT_WIDTH, D_MODEL)),
    })
    return inputs


def reference(x, c, ctx, c_ctx,
              l0_ada_w, l0_ada_b, l0_norm_g, l0_ffn_wg, l0_ffn_wu, l0_ffn_wd,
              l0_w_in, l0_mla_qa_g, l0_mla_wqb, l0_mla_kva_g, l0_mla_wkvb, l0_mla_q_g, l0_mla_k_g,
              l0_swa_q_g, l0_swa_k_g, l0_swa_sink, l0_w_out,
              l1_ada_w, l1_ada_b, l1_norm_g, l1_ffn_wg, l1_ffn_wu, l1_ffn_wd,
              l1_w_in, l1_q_g, l1_k_g, l1_lambda_q1, l1_lambda_k1, l1_lambda_q2, l1_lambda_k2,
              l1_subln_g, l1_w_out):
    n_rows = x.shape[1] // GRID_W
    rope_mla = axial_rope(n_rows, MLA_ROPE)
    rope_swa = axial_rope(n_rows, SWA_HEAD_DIM)
    rope_diff = axial_rope(n_rows, DIFF_HEAD_DIM)

    layers = [
        ((l0_ada_w, l0_ada_b, l0_norm_g, l0_ffn_wg, l0_ffn_wu, l0_ffn_wd),
         functools.partial(mixer_mla_swa, rope_mla=rope_mla, rope_swa=rope_swa, w_in=l0_w_in,
                           mla_qa_g=l0_mla_qa_g, mla_wqb=l0_mla_wqb, mla_kva_g=l0_mla_kva_g,
                           mla_wkvb=l0_mla_wkvb, mla_q_g=l0_mla_q_g, mla_k_g=l0_mla_k_g,
                           swa_q_g=l0_swa_q_g, swa_k_g=l0_swa_k_g, swa_sink=l0_swa_sink, w_out=l0_w_out)),
        ((l1_ada_w, l1_ada_b, l1_norm_g, l1_ffn_wg, l1_ffn_wu, l1_ffn_wd),
         functools.partial(mixer_diff, rope=rope_diff, w_in=l1_w_in, q_g=l1_q_g, k_g=l1_k_g,
                           lambda_q1=l1_lambda_q1, lambda_k1=l1_lambda_k1,
                           lambda_q2=l1_lambda_q2, lambda_k2=l1_lambda_k2,
                           subln_g=l1_subln_g, w_out=l1_w_out, lambda_init=lambda_init_fn(1))),
    ]

    h, hc = x, ctx
    for layer in range(DEPTH):
        (ada_w, ada_b, norm_g, wg, wu, wd), mixer = layers[layer]
        need_ctx = layer < DEPTH - 1
        mod = (jax.nn.silu(c) @ ada_w + ada_b).reshape(c.shape[0], 1, N_MOD, D_MODEL)
        mod_c = (jax.nn.silu(c_ctx) @ ada_w + ada_b).reshape(N_MOD, D_MODEL)
        h = h + 0.5 * mod[..., 2, :] * swiglu(adaln(h, norm_g[0], mod, 0), wg[0], wu[0], wd[0])
        hc = hc + 0.5 * mod_c[..., 2, :] * swiglu(adaln(hc, norm_g[0], mod_c, 0), wg[0], wu[0], wd[0])
        y, y_c = mixer(adaln(h, norm_g[1], mod, 1), adaln(hc, norm_g[1], mod_c, 1), need_ctx)
        h = h + mod[..., 5, :] * y
        h = h + 0.5 * mod[..., 8, :] * swiglu(adaln(h, norm_g[2], mod, 2), wg[1], wu[1], wd[1])
        if need_ctx:
            hc = hc + mod_c[..., 5, :] * y_c
            hc = hc + 0.5 * mod_c[..., 8, :] * swiglu(adaln(hc, norm_g[2], mod_c, 2), wg[1], wu[1], wd[1])
    return h
```

```cpp
#include <hip/hip_runtime.h>
#include <hip/hip_cooperative_groups.h>
#include <cstdio>
#include <cstdint>
namespace cg = cooperative_groups;
namespace pg8 {
#define PG8_LAS __attribute__((address_space(3)))
typedef unsigned short bf16_t;
typedef short bf16x8 __attribute__((ext_vector_type(8)));
typedef float f32x4 __attribute__((ext_vector_type(4)));
typedef unsigned u32x4 __attribute__((ext_vector_type(4)));
constexpr int BM = 256, BK = 64, HALF = 128, HTB = HALF * BK * 2  , STAGE_BYTES = 8 * HTB, NXCD = 8, WGM = 8;

__host__ __device__ __forceinline__ int lds_byte(int r, int c) { const int st = (r >> 4) * 2 + (c >> 5), rr = r & 15, cc = c & 31, ob = rr * 64 + cc * 2; return st * 1024 + (ob ^ (((ob >> 9) & 1) << 5)); }
__host__ __device__ __forceinline__ void stage_rc(int b, int& R, int& C) { const int st = b / 1024, sb = b % 1024, swz = sb ^ (((sb >> 9) & 1) << 5); R = (st >> 1) * 16 + swz / 64; C = (st & 1) * 32 + (swz % 64) / 2; }
__host__ __device__ __forceinline__ int perm32(int rho) { const int n = rho >> 4, i = rho & 15; return 8 * (i >> 2) + 4 * n + (i & 3); }

struct Unit { int pm, pn, kinfo; };
struct Gemm { const bf16_t* A; const bf16_t* Bt; int M, N, K, lda; };

struct StaticOrder {
    int nM, nN, nwg, G, c;
    __host__ __device__ void init(int M, int N, int G_, int c_) { nM = M / BM; nN = N / BM; nwg = nM * nN; G = G_; c = c_; }
    __host__ __device__ bool next(int i, Unit& u) const {
        const long L = (long)i * G + c; if (L >= nwg) return false;
        int wgid = (int)L; { const int q = nwg / NXCD, r = nwg % NXCD, xcd = wgid % NXCD, off = wgid / NXCD; wgid = (xcd < r ? xcd * (q + 1) : r * (q + 1) + (xcd - r) * q) + off; }
        const int nig = WGM * nN, gid = wgid / nig, fm = gid * WGM, gsz = (nM - fm) < WGM ? (nM - fm) : WGM;
        u.pm = fm + ((wgid % nig) % gsz); u.pn = (wgid % nig) / gsz; u.kinfo = 0; return true;
    }
    __device__ __forceinline__ void a_ready(const Unit&) const {}
    __device__ __forceinline__ void done(const Unit&) const {}
};


struct SplitCtxOrder {
    StaticOrder lat; int nmine, nN_, G_, c_, nkA, nkB, nparts;
    __host__ __device__ void init(int Mlat, int N, int G, int c, int ntK, bool with_ctx) { lat.init(Mlat, N, G, c); nmine = c < lat.nwg ? (lat.nwg - c + G - 1) / G : 0; nN_ = N / BM; G_ = G; c_ = c;
        nkA = ((ntK / 4 + 1) / 2) * 2; nkB = (ntK - 2 * nkA) / 2; nparts = with_ctx ? 16 * nN_ * 4 : 0; }
    __host__ __device__ bool next(int i, Unit& u) const {
        if (i < nmine) return lat.next(i, u);
        const int idx = (i - nmine) * G_ + c_; if (idx >= nparts) return false;
        const int kp = idx & 3, tile = idx >> 2;
        u.pm = lat.nM + tile / nN_; u.pn = tile % nN_;
        const int k0 = kp < 2 ? kp * nkA : 2 * nkA + (kp - 2) * nkB, nk = kp < 2 ? nkA : nkB; u.kinfo = k0 | (nk << 8) | (kp << 16); return true;
    }
    __device__ __forceinline__ void a_ready(const Unit&) const {}
    __device__ __forceinline__ void done(const Unit&) const {}
};
__device__ __forceinline__ unsigned cvt_pk_bf16(float lo, float hi) { unsigned r; asm volatile("v_cvt_pk_bf16_f32 %0, %1, %2" : "=v"(r) : "v"(lo), "v"(hi)); return r; }
typedef float f32x2 __attribute__((ext_vector_type(2)));
__device__ __forceinline__ unsigned pk_bf16(float lo, float hi) { typedef __bf16 b2_t __attribute__((ext_vector_type(2))); f32x2 v = {lo, hi}; b2_t b = __builtin_convertvector(v, b2_t); return __builtin_bit_cast(unsigned, b); }
__device__ __forceinline__ float silu_f(float x) { return x * __builtin_amdgcn_rcpf(1.0f + __builtin_amdgcn_exp2f(-1.4426950408889634f * x)); }

struct EpiStoreBf16 {
    static constexpr bool PERM = true, AFTER_DRAIN = false;
    bf16_t* O; int ldc;
    __device__ __forceinline__ void operator()(const f32x4 (&acc)[2][2][4][2], const Unit& u, int wr, int wc, int fr, int fq) const {
        const int row0 = u.pm * BM + wr * 64 + fr, col0 = u.pn * BM + wc * 32 + 8 * fq;
#pragma unroll
        for (int ai = 0; ai < 2; ++ai)
#pragma unroll
            for (int m = 0; m < 4; ++m) { bf16_t* rowp = O + (size_t)(row0 + ai * HALF + m * 16) * ldc + col0;
#pragma unroll
                for (int bj = 0; bj < 2; ++bj) { const f32x4 v0 = acc[ai][bj][m][0], v1 = acc[ai][bj][m][1];
                    u32x4 w; w.x = pk_bf16(v0[0], v0[1]); w.y = pk_bf16(v0[2], v0[3]); w.z = pk_bf16(v1[0], v1[1]); w.w = pk_bf16(v1[2], v1[3]);
                    *(u32x4*)(rowp + bj * HALF) = w; } }
    }
};
struct EpiSwiglu {
    static constexpr bool PERM = true, AFTER_DRAIN = false;
    bf16_t* U; int ldu;
    __device__ __forceinline__ void operator()(const f32x4 (&acc)[2][2][4][2], const Unit& u, int wr, int wc, int fr, int fq) const {
        const int row0 = u.pm * BM + wr * 64 + fr, col0 = u.pn * HALF + wc * 32 + 8 * fq;
#pragma unroll
        for (int ai = 0; ai < 2; ++ai)
#pragma unroll
            for (int m = 0; m < 4; ++m) { bf16_t* rowp = U + (size_t)(row0 + ai * HALF + m * 16) * ldu + col0;
                const f32x4 g0 = acc[ai][0][m][0], g1 = acc[ai][0][m][1], u0 = acc[ai][1][m][0], u1 = acc[ai][1][m][1];
                u32x4 w;
                w.x = pk_bf16(silu_f(g0[0]) * u0[0], silu_f(g0[1]) * u0[1]); w.y = pk_bf16(silu_f(g0[2]) * u0[2], silu_f(g0[3]) * u0[3]);
                w.z = pk_bf16(silu_f(g1[0]) * u1[0], silu_f(g1[1]) * u1[1]); w.w = pk_bf16(silu_f(g1[2]) * u1[2], silu_f(g1[3]) * u1[3]);
                *(u32x4*)rowp = w; }
    }
};
struct EpiResid {
    static constexpr bool PERM = false, AFTER_DRAIN = false;
    const float* base_lat; const float* base_ctx; float* out_lat; float* out_ctx; const float* gate; float gs;
    __device__ __forceinline__ void operator()(const f32x4 (&acc)[2][2][4][2], const Unit& u, int wr, int wc, int fr, int fq) const {
        const bool isctx = u.pm >= 128; const int bidx = isctx ? 16 : (u.pm >> 3);
        const float* base = isctx ? base_ctx : base_lat; float* out = isctx ? out_ctx : out_lat;
        const int rloc = (isctx ? (u.pm - 128) : u.pm) * BM + wr * 64 + fr, col0 = u.pn * BM + wc * 32 + 4 * fq;
        f32x4 gv[2][2];
#pragma unroll
        for (int bj = 0; bj < 2; ++bj)
#pragma unroll
            for (int n = 0; n < 2; ++n) gv[bj][n] = *(const f32x4*)(gate + (size_t)bidx * 9216 + col0 + bj * HALF + n * 16) * gs;
#pragma unroll
        for (int ai = 0; ai < 2; ++ai)
#pragma unroll
            for (int m = 0; m < 4; ++m) { const size_t off = (size_t)(rloc + ai * HALF + m * 16) * 1024 + col0;
#pragma unroll
                for (int bj = 0; bj < 2; ++bj)
#pragma unroll
                    for (int n = 0; n < 2; ++n) { const f32x4 b = *(const f32x4*)(base + off + bj * HALF + n * 16);
                        *(f32x4*)(out + off + bj * HALF + n * 16) = b + gv[bj][n] * acc[ai][bj][m][n]; } }
    }
};

typedef _Float16 f16x8 __attribute__((ext_vector_type(8)));
typedef _Float16 f16x4 __attribute__((ext_vector_type(4)));
template <bool BASE16, bool OUT16> struct EpiResidPart {
    static constexpr bool PERM = true, AFTER_DRAIN = false;
    const void* base_lat; void* out_lat; _Float16* part; const float* gate; float gs; int nMlat;
    __device__ __forceinline__ void operator()(const f32x4 (&acc)[2][2][4][2], const Unit& u, int wr, int wc, int fr, int fq) const {
        const bool isctx = u.pm >= nMlat; const int bidx = isctx ? 16 : (u.pm >> 3);
        const int rloc = (isctx ? (u.pm - nMlat) : u.pm) * BM + wr * 64 + fr, col0 = u.pn * BM + wc * 32 + 8 * fq;
        f32x4 gv[2][2];
#pragma unroll
        for (int bj = 0; bj < 2; ++bj)
#pragma unroll
            for (int n = 0; n < 2; ++n) gv[bj][n] = *(const f32x4*)(gate + (size_t)bidx * 9216 + col0 + bj * HALF + n * 4) * gs;
        if (!isctx) {
#pragma unroll
            for (int ai = 0; ai < 2; ++ai) {
                f32x4 pre[4][2][2];
#pragma unroll
                for (int m = 0; m < 4; ++m) { const size_t off = (size_t)(rloc + ai * HALF + m * 16) * 1024 + col0;
#pragma unroll
                    for (int bj = 0; bj < 2; ++bj) {
                        if (BASE16) { const f16x8 hb = *(const f16x8*)((const _Float16*)base_lat + off + bj * HALF);
                            pre[m][bj][0] = (f32x4){(float)hb[0], (float)hb[1], (float)hb[2], (float)hb[3]}; pre[m][bj][1] = (f32x4){(float)hb[4], (float)hb[5], (float)hb[6], (float)hb[7]}; }
                        else { pre[m][bj][0] = *(const f32x4*)((const float*)base_lat + off + bj * HALF); pre[m][bj][1] = *(const f32x4*)((const float*)base_lat + off + bj * HALF + 4); } } }
                asm volatile("" ::: "memory");
#pragma unroll
                for (int m = 0; m < 4; ++m) { const size_t off = (size_t)(rloc + ai * HALF + m * 16) * 1024 + col0;
#pragma unroll
                    for (int bj = 0; bj < 2; ++bj) { const f32x4 o0 = pre[m][bj][0] + gv[bj][0] * acc[ai][bj][m][0], o1 = pre[m][bj][1] + gv[bj][1] * acc[ai][bj][m][1];
                        if (OUT16) { f16x8 ho; ho[0] = (_Float16)o0[0]; ho[1] = (_Float16)o0[1]; ho[2] = (_Float16)o0[2]; ho[3] = (_Float16)o0[3]; ho[4] = (_Float16)o1[0]; ho[5] = (_Float16)o1[1]; ho[6] = (_Float16)o1[2]; ho[7] = (_Float16)o1[3];
                            *(f16x8*)((_Float16*)out_lat + off + bj * HALF) = ho; }
                        else { *(f32x4*)((float*)out_lat + off + bj * HALF) = o0; *(f32x4*)((float*)out_lat + off + bj * HALF + 4) = o1; } } }
                asm volatile("" ::: "memory");
            }
        } else {
            _Float16* pp = part + (size_t)(u.kinfo >> 16) * (4096 * 1024);
#pragma unroll
            for (int ai = 0; ai < 2; ++ai)
#pragma unroll
                for (int m = 0; m < 4; ++m) { const size_t off = (size_t)(rloc + ai * HALF + m * 16) * 1024 + col0;
#pragma unroll
                    for (int bj = 0; bj < 2; ++bj) { const f32x4 p0 = gv[bj][0] * acc[ai][bj][m][0], p1 = gv[bj][1] * acc[ai][bj][m][1];
                        f16x8 hp; hp[0] = (_Float16)p0[0]; hp[1] = (_Float16)p0[1]; hp[2] = (_Float16)p0[2]; hp[3] = (_Float16)p0[3]; hp[4] = (_Float16)p1[0]; hp[5] = (_Float16)p1[1]; hp[6] = (_Float16)p1[2]; hp[7] = (_Float16)p1[3];
                        *(f16x8*)(pp + off + bj * HALF) = hp; } }
        }
    }
};

struct EpiQKV1 {
    static constexpr bool PERM = true, AFTER_DRAIN = false;
    bf16_t* P; int ldp; const float* qg; const float* kg; const float* cs; const float* sn; int nMlat; float qscale, eps;
    __device__ __forceinline__ void operator()(const f32x4 (&acc)[2][2][4][2], const Unit& u, int wr, int wc, int fr, int fq) const {
        const int row0 = u.pm * BM + wr * 64 + fr, colb = u.pn * BM + wc * 64 + 8 * fq;
        if (u.pn >= 8) {
#pragma unroll
            for (int ai = 0; ai < 2; ++ai)
#pragma unroll
                for (int m = 0; m < 4; ++m) { bf16_t* rowp = P + (size_t)(row0 + ai * HALF + m * 16) * ldp + colb;
#pragma unroll
                    for (int bj = 0; bj < 2; ++bj) { const f32x4 v0 = acc[ai][bj][m][0], v1 = acc[ai][bj][m][1];
                        u32x4 w; w.x = pk_bf16(v0[0], v0[1]); w.y = pk_bf16(v0[2], v0[3]); w.z = pk_bf16(v1[0], v1[1]); w.w = pk_bf16(v1[2], v1[3]);
                        *(u32x4*)(rowp + 32 * bj) = w; } }
            return;
        }
        const bool isq = u.pn < 4, lat = u.pm < nMlat; const float* g = isq ? qg : kg; const float osc = isq ? qscale : 1.0f;
        f32x4 g1[2], g2[2];
#pragma unroll
        for (int n = 0; n < 2; ++n) { g1[n] = *(const f32x4*)(g + 8 * fq + 4 * n) * osc; g2[n] = *(const f32x4*)(g + 32 + 8 * fq + 4 * n) * osc; }
        const int lane = fq * 16 + fr;
#pragma unroll
        for (int ai = 0; ai < 2; ++ai)
#pragma unroll
            for (int m = 0; m < 4; ++m) { const int row = row0 + ai * HALF + m * 16;
                const f32x4 a0 = acc[ai][0][m][0], a1 = acc[ai][0][m][1], b0 = acc[ai][1][m][0], b1 = acc[ai][1][m][1];
                float ss = ((a0[0] * a0[0] + a0[1] * a0[1]) + (a0[2] * a0[2] + a0[3] * a0[3])) + ((a1[0] * a1[0] + a1[1] * a1[1]) + (a1[2] * a1[2] + a1[3] * a1[3]))
                         + ((b0[0] * b0[0] + b0[1] * b0[1]) + (b0[2] * b0[2] + b0[3] * b0[3])) + ((b1[0] * b1[0] + b1[1] * b1[1]) + (b1[2] * b1[2] + b1[3] * b1[3]));
                ss += __int_as_float(__builtin_amdgcn_ds_bpermute((lane ^ 16) << 2, __float_as_int(ss)));
                ss += __int_as_float(__builtin_amdgcn_ds_bpermute((lane ^ 32) << 2, __float_as_int(ss)));
                const float r = 1.0f / sqrtf(ss * (1.0f / 64.0f) + eps);
                f32x4 y10 = a0 * r * g1[0], y11 = a1 * r * g1[1], y20 = b0 * r * g2[0], y21 = b1 * r * g2[1];
                if (lat) { const int t = row & 2047;
                    const f32x4 c0 = *(const f32x4*)(cs + t * 32 + 8 * fq), c1 = *(const f32x4*)(cs + t * 32 + 8 * fq + 4), s0 = *(const f32x4*)(sn + t * 32 + 8 * fq), s1 = *(const f32x4*)(sn + t * 32 + 8 * fq + 4);
                    const f32x4 o10 = y10 * c0 - y20 * s0, o20 = y10 * s0 + y20 * c0, o11 = y11 * c1 - y21 * s1, o21 = y11 * s1 + y21 * c1;
                    y10 = o10; y20 = o20; y11 = o11; y21 = o21; }
                bf16_t* rowp = P + (size_t)row * ldp + colb;
                u32x4 w1; w1.x = pk_bf16(y10[0], y10[1]); w1.y = pk_bf16(y10[2], y10[3]); w1.z = pk_bf16(y11[0], y11[1]); w1.w = pk_bf16(y11[2], y11[3]);
                u32x4 w2; w2.x = pk_bf16(y20[0], y20[1]); w2.y = pk_bf16(y20[2], y20[3]); w2.z = pk_bf16(y21[0], y21[1]); w2.w = pk_bf16(y21[2], y21[3]);
                *(u32x4*)(rowp) = w1; *(u32x4*)(rowp + 32) = w2; }
    }
};

template <class Epi, class Sched, bool ALIGN_EPI = false, bool SP2 = false>
__device__ __forceinline__ void gemm_phase(PG8_LAS unsigned char* lds, const Gemm g, const Sched& S, const Epi& E, int tid_in) {
    const int tid = tid_in, wid = __builtin_amdgcn_readfirstlane(tid >> 6), lane = tid & 63, wr = wid >> 2, wc = wid & 3, fr = lane & 15, fq = lane >> 4;
    const int K = g.K, nt = K / BK;
    unsigned voffA[2], voffB[2];
#pragma unroll
    for (int i = 0; i < 2; ++i) { int R, C; stage_rc(tid * 16 + i * 8192, R, C); const int Rb = Epi::PERM ? ((R & ~31) + perm32(R & 31)) : R;
        voffA[i] = (unsigned)(R * g.lda + C) * 2u; voffB[i] = (unsigned)(Rb * K + C) * 2u; }
    const size_t kstep = (size_t)(BK * 2);
    const size_t hstepB = (size_t)HALF * K * 2, hstepA = (size_t)HALF * g.lda * 2;
    const size_t tstepA = 2 * hstepA, tstepB = 2 * hstepB;
    const unsigned ldsw = (unsigned)wid * 1024u;
    const int aoff = lds_byte(wr * 64 + fr, fq * 8), boff = lds_byte(wc * 32 + fr, fq * 8);
#define PG8_SA(b, h) (((b) * 2 + (h)) * HTB)
#define PG8_SB(b, h) ((4 + (b) * 2 + (h)) * HTB)
#define PG8_STAGE(bufoff, gbase, voff) do { _Pragma("unroll") for (int _i = 0; _i < 2; ++_i) \
        __builtin_amdgcn_global_load_lds((const unsigned*)((const char*)(gbase) + (voff)[_i]), (PG8_LAS unsigned*)(lds + (bufoff) + ldsw + _i * 8192), 16, 0, 0); } while (0)
#define PG8_LDA(dst, b, h) do { _Pragma("unroll") for (int m = 0; m < 4; ++m) _Pragma("unroll") for (int k = 0; k < 2; ++k) dst[m][k] = *(const PG8_LAS bf16x8*)(lds + PG8_SA(b, h) + aoff + m * 2048 + k * 1024); } while (0)
#define PG8_LDB(dst, b, h) do { _Pragma("unroll") for (int n = 0; n < 2; ++n) _Pragma("unroll") for (int k = 0; k < 2; ++k) dst[n][k] = *(const PG8_LAS bf16x8*)(lds + PG8_SB(b, h) + boff + n * 2048 + k * 1024); } while (0)
#define PG8_MMA(ai, bj, At, Bt) do { __builtin_amdgcn_s_setprio(1); _Pragma("unroll") for (int m = 0; m < 4; ++m) _Pragma("unroll") for (int n = 0; n < 2; ++n) _Pragma("unroll") for (int k = 0; k < 2; ++k) \
        acc[ai][bj][m][n] = __builtin_amdgcn_mfma_f32_16x16x32_bf16(Bt[n][k], At[m][k], acc[ai][bj][m][n], 0, 0, 0); __builtin_amdgcn_s_setprio(0); } while (0)
#define PG8_WAIT_V(n) asm volatile("s_waitcnt vmcnt(" #n ")" ::: "memory")
#define PG8_WAIT_L(n) asm volatile("s_waitcnt lgkmcnt(" #n ")" ::: "memory")
#define PG8_BAR __builtin_amdgcn_s_barrier()
#define PG8_SCHED __builtin_amdgcn_sched_barrier(0)
    Unit cur, nxt; int ui = 0;
    if (!S.next(0, cur)) return;
    f32x4 acc[2][2][4][2];
#pragma unroll
    for (int a = 0; a < 2; ++a)
#pragma unroll
        for (int b = 0; b < 2; ++b)
#pragma unroll
            for (int m = 0; m < 4; ++m)
#pragma unroll
                for (int n = 0; n < 2; ++n) acc[a][b][m][n] = (f32x4){0.f, 0.f, 0.f, 0.f};
    bf16x8 At[4][2], B0[2][2], B1[2][2];
    const char* cA = (const char*)g.A + (size_t)cur.pm * tstepA + (size_t)(cur.kinfo & 255) * kstep; const char* cB = (const char*)g.Bt + (size_t)cur.pn * tstepB + (size_t)(cur.kinfo & 255) * kstep;
    S.a_ready(cur);
    if constexpr (SP2) {
        PG8_STAGE(PG8_SB(0, 0), cB, voffB); PG8_STAGE(PG8_SB(0, 1), cB + hstepB, voffB); PG8_STAGE(PG8_SA(0, 0), cA, voffA); PG8_STAGE(PG8_SA(0, 1), cA + hstepA, voffA);
        if (wr == 1) PG8_BAR;
        PG8_WAIT_V(2); PG8_BAR;
        PG8_STAGE(PG8_SB(1, 0), cB + kstep, voffB); PG8_STAGE(PG8_SA(1, 0), cA + kstep, voffA); PG8_STAGE(PG8_SB(1, 1), cB + hstepB + kstep, voffB);
        PG8_WAIT_V(6); PG8_BAR;
    } else {
        PG8_STAGE(PG8_SB(0, 0), cB, voffB); PG8_STAGE(PG8_SA(0, 0), cA, voffA); PG8_STAGE(PG8_SB(0, 1), cB + hstepB, voffB); PG8_STAGE(PG8_SA(0, 1), cA + hstepA, voffA);
        if (wr == 1) PG8_BAR;
        PG8_WAIT_V(4); PG8_BAR;
        PG8_STAGE(PG8_SB(1, 0), cB + kstep, voffB); PG8_STAGE(PG8_SA(1, 0), cA + kstep, voffA); PG8_STAGE(PG8_SB(1, 1), cB + hstepB + kstep, voffB);
        PG8_WAIT_V(6); PG8_BAR;
    }
    for (;;) {
        const bool has_next = S.next(ui + 1, nxt);
        const char* nA = has_next ? (const char*)g.A + (size_t)nxt.pm * tstepA + (size_t)(nxt.kinfo & 255) * kstep : cA; const char* nB = has_next ? (const char*)g.Bt + (size_t)nxt.pn * tstepB + (size_t)(nxt.kinfo & 255) * kstep : cB;
        const int cnt_ = cur.kinfo ? ((cur.kinfo >> 8) & 255) : nt;
        for (int t = 0; t < cnt_; t += 2) {
            const bool last = (t == cnt_ - 2);
            const char* a1 = cA + (size_t)(t + 1) * kstep;
            const char* a2 = last ? nA : cA + (size_t)(t + 2) * kstep; const char* b2 = last ? nB : cB + (size_t)(t + 2) * kstep;
            const char* a3 = a2 + kstep; const char* b3 = b2 + kstep;
            if (last && has_next) S.a_ready(nxt);
            if constexpr (SP2) {
            PG8_LDB(B0, 0, 0); PG8_LDB(B1, 0, 1); PG8_SCHED; PG8_LDA(At, 0, 0); PG8_STAGE(PG8_SA(1, 1), a1 + hstepA, voffA);
            PG8_WAIT_V(8); PG8_WAIT_L(0); PG8_BAR; PG8_MMA(0, 0, At, B0); PG8_MMA(0, 1, At, B1); PG8_BAR; PG8_SCHED;
            PG8_LDA(At, 0, 1); PG8_STAGE(PG8_SB(0, 0), b2, voffB); PG8_STAGE(PG8_SB(0, 1), b2 + hstepB, voffB); PG8_STAGE(PG8_SA(0, 0), a2, voffA);
            PG8_WAIT_V(8); PG8_WAIT_L(0); PG8_BAR; PG8_MMA(1, 0, At, B0); PG8_MMA(1, 1, At, B1); PG8_BAR; PG8_SCHED;
            PG8_LDB(B0, 1, 0); PG8_LDB(B1, 1, 1); PG8_SCHED; PG8_LDA(At, 1, 0); PG8_STAGE(PG8_SA(0, 1), a2 + hstepA, voffA);
            PG8_WAIT_V(8); PG8_WAIT_L(0); PG8_BAR; PG8_MMA(0, 0, At, B0); PG8_MMA(0, 1, At, B1); PG8_BAR; PG8_SCHED;
            PG8_LDA(At, 1, 1); PG8_STAGE(PG8_SB(1, 0), b3, voffB); PG8_STAGE(PG8_SB(1, 1), b3 + hstepB, voffB); PG8_STAGE(PG8_SA(1, 0), a3, voffA);
            PG8_WAIT_V(8); PG8_WAIT_L(0); PG8_BAR; PG8_MMA(1, 0, At, B0); PG8_MMA(1, 1, At, B1); PG8_BAR; PG8_SCHED;
            } else {
            PG8_LDB(B0, 0, 0); PG8_SCHED; PG8_LDA(At, 0, 0); PG8_STAGE(PG8_SA(1, 1), a1 + hstepA, voffA);
            PG8_WAIT_L(8); PG8_BAR; PG8_WAIT_L(0); PG8_MMA(0, 0, At, B0); PG8_BAR; PG8_SCHED;
            PG8_LDB(B1, 0, 1); PG8_STAGE(PG8_SB(0, 0), b2, voffB);
            PG8_BAR; PG8_WAIT_L(0); PG8_MMA(0, 1, At, B1); PG8_BAR;
            PG8_LDA(At, 0, 1); PG8_STAGE(PG8_SA(0, 0), a2, voffA);
            PG8_BAR; PG8_WAIT_L(0); PG8_MMA(1, 0, At, B0); PG8_BAR; PG8_SCHED;
            PG8_STAGE(PG8_SB(0, 1), b2 + hstepB, voffB);
            PG8_WAIT_V(6); PG8_BAR; PG8_MMA(1, 1, At, B1); PG8_BAR;
            PG8_LDB(B0, 1, 0); PG8_SCHED; PG8_LDA(At, 1, 0); PG8_STAGE(PG8_SA(0, 1), a2 + hstepA, voffA);
            PG8_WAIT_L(8); PG8_BAR; PG8_WAIT_L(0); PG8_MMA(0, 0, At, B0); PG8_BAR; PG8_SCHED;
            PG8_LDB(B1, 1, 1); PG8_STAGE(PG8_SB(1, 0), b3, voffB);
            PG8_BAR; PG8_WAIT_L(0); PG8_MMA(0, 1, At, B1); PG8_BAR;
            PG8_LDA(At, 1, 1); PG8_STAGE(PG8_SA(1, 0), a3, voffA);
            PG8_BAR; PG8_WAIT_L(0); PG8_MMA(1, 0, At, B0); PG8_BAR; PG8_SCHED;
            PG8_STAGE(PG8_SB(1, 1), b3 + hstepB, voffB);
            PG8_WAIT_V(6); PG8_BAR; PG8_MMA(1, 1, At, B1); PG8_BAR;
            }
        }
        if constexpr (ALIGN_EPI) { if (wr == 0) PG8_BAR; }
        if constexpr (!Epi::AFTER_DRAIN) { E(acc, cur, wr, wc, fr, fq); S.done(cur); }
        if (!has_next) break;
#pragma unroll
        for (int a = 0; a < 2; ++a)
#pragma unroll
            for (int b = 0; b < 2; ++b)
#pragma unroll
                for (int m = 0; m < 4; ++m)
#pragma unroll
                    for (int n = 0; n < 2; ++n) acc[a][b][m][n] = (f32x4){0.f, 0.f, 0.f, 0.f};
        cur = nxt; cA = nA; cB = nB; ++ui;
        if constexpr (ALIGN_EPI) { if (wr == 1) PG8_BAR; }
    }
    PG8_WAIT_V(0);
    if constexpr (!ALIGN_EPI) { if (wr == 0) PG8_BAR; }
    PG8_BAR;
    if constexpr (Epi::AFTER_DRAIN) { E.fused(acc, cur, wr, wc, fr, fq, lds, wid, lane); S.done(cur); }
#undef PG8_SA
#undef PG8_SB
#undef PG8_STAGE
#undef PG8_LDA
#undef PG8_LDB
#undef PG8_MMA
#undef PG8_WAIT_V
#undef PG8_WAIT_L
#undef PG8_BAR
#undef PG8_SCHED
}
}

#define REP_ATT0 1
#define REP_ATT1 1
#define REP_GU 1
#define REP_NORM 1
#define REP_SYNC 0
#define LAS __attribute__((address_space(3)))
typedef unsigned short bf16_t;
typedef short bf16x8 __attribute__((ext_vector_type(8)));
typedef short s16x4 __attribute__((ext_vector_type(4)));
typedef short v4i16_t __attribute__((ext_vector_type(4)));
typedef float f32x16 __attribute__((ext_vector_type(16)));
typedef float f32x4 __attribute__((ext_vector_type(4)));
typedef unsigned u32x4 __attribute__((ext_vector_type(4)));
typedef unsigned u32x2 __attribute__((ext_vector_type(2)));
using pg8::pk_bf16;

constexpr int D = 1024, NB = 16, SEQ = 2048, CTX = 256, DFF = 2816;
constexpr int ML = NB * SEQ, MC = NB * CTX, MT = ML + MC;
constexpr int P0W = 1280, P1W = 3072;
constexpr int P0P = 1408, P1P = 3200, KVP = 1152, MKP = 896;
constexpr float EPS = 1e-6f, LOG2E = 1.4426950408889634f;
constexpr float LAMBDA_INIT = 0.35550906759096927f;
constexpr size_t MiB = 1u << 20;
constexpr size_t WS_MOD = 0;
constexpr size_t WS_ROPE = 2 * MiB;
constexpr size_t WS_BAR = 3 * MiB;
constexpr size_t WS_HC = 4 * MiB;
constexpr size_t WS_W = 20 * MiB;
constexpr size_t WS_HL = 100 * MiB, WS_HCH = 164 * MiB;
constexpr size_t WS_A = 100 * MiB;
constexpr size_t WS_P = 172 * MiB;
constexpr size_t WS_QF = 271 * MiB, WS_KVF = 325 * MiB;
constexpr size_t WS_MK = 406 * MiB;
constexpr size_t WS_PART = 400 * MiB;
constexpr size_t WS_END = 469 * MiB;
static_assert((size_t)MT * P0P * 2 <= 99 * MiB && (size_t)MT * KVP * 2 <= 81 * MiB && (size_t)MT * MKP * 2 <= 63 * MiB && (size_t)MT * P1P * 2 <= 225 * MiB && (size_t)MT * 768 * 2 <= 54 * MiB, "ws map");
constexpr size_t SZ_GU = (size_t)5632 * 1024, SZ_WD = (size_t)1024 * 2816;
constexpr size_t WO_GU = 0, WO_WD = WO_GU + 4 * SZ_GU, WO_WIN0 = WO_WD + 4 * SZ_WD, WO_WQB = WO_WIN0 + (size_t)1280 * 1024, WO_WKVB = WO_WQB + (size_t)768 * 256,
                 WO_WOUT0 = WO_WKVB + (size_t)1024 * 128, WO_WIN1 = WO_WOUT0 + (size_t)1024 * 1024, WO_WOUT1 = WO_WIN1 + (size_t)3072 * 1024, WO_END = WO_WOUT1 + (size_t)1024 * 1024;
static_assert(WO_END * 2 <= 80 * MiB, "weights fit");
constexpr int LDS_BYTES = 131072 + 1024;

__device__ __forceinline__ float bflo(unsigned u) { return __uint_as_float(u << 16); }
__device__ __forceinline__ float bfhi(unsigned u) { return __uint_as_float(u & 0xffff0000u); }
__device__ __forceinline__ float shx(float v, int mask, int lane) { return __int_as_float(__builtin_amdgcn_ds_bpermute((lane ^ mask) << 2, __float_as_int(v))); }
__device__ __forceinline__ float wave_sum(float v, int lane) {
#pragma unroll
    for (int o = 1; o < 64; o <<= 1) v += shx(v, o, lane);
    return v;
}
#define LDS_WAIT() asm volatile("s_waitcnt lgkmcnt(0)" ::: "memory")

__device__ __forceinline__ void conv_item(const float* __restrict__ W, int K, int N, bf16_t* WT, int mode, LAS float* scr, int item, int lane) {
    const int nblk = N / 32, kb = item / nblk, nb = item % nblk, k0 = 64 * kb, n0 = 32 * nb;
#pragma unroll 8
    for (int i = 0; i < 32; ++i) { const int kk = 2 * i + (lane >> 5); scr[kk * 33 + (lane & 31)] = W[(size_t)(k0 + kk) * N + n0 + (lane & 31)]; }
    LDS_WAIT();
    const int drow0 = mode == 0 ? n0 : mode == 3 ? ((n0 & ~255) + 128 * ((n0 >> 5) & 1) + 32 * ((n0 >> 6) & 3))
                                         : ((n0 >> 7) * 256 + (n0 & 127) + (mode == 2 ? 128 : 0));
    const int c = lane & 7;
#pragma unroll
    for (int j = 0; j < 4; ++j) { const int n = (lane >> 3) + 8 * j; const LAS float* s = scr + (8 * c) * 33 + n;
        u32x4 o; o.x = pk_bf16(s[0 * 33], s[1 * 33]); o.y = pk_bf16(s[2 * 33], s[3 * 33]); o.z = pk_bf16(s[4 * 33], s[5 * 33]); o.w = pk_bf16(s[6 * 33], s[7 * 33]);
        *(u32x4*)(WT + (size_t)(drow0 + n) * K + k0 + 8 * c) = o; }
    LDS_WAIT();
}
__device__ __forceinline__ void sincos_d(double a, float& sn, float& cs) {
    const double k = __builtin_rint(a * 0.63661977236758134308); const double r = a - k * 1.57079632679489661923; const double r2 = r * r;
    const double s = r * (1.0 + r2 * (-1.0 / 6 + r2 * (1.0 / 120 + r2 * (-1.0 / 5040 + r2 * (1.0 / 362880 + r2 * (-1.0 / 39916800))))));
    const double c = 1.0 + r2 * (-0.5 + r2 * (1.0 / 24 + r2 * (-1.0 / 720 + r2 * (1.0 / 40320 + r2 * (-1.0 / 3628800 + r2 * (1.0 / 479001600))))));
    const int q = ((int)k) & 3;
    const double so = (q == 0) ? s : (q == 1) ? c : (q == 2) ? -s : -c;
    const double co = (q == 0) ? c : (q == 1) ? -s : (q == 2) ? -c : s;
    sn = (float)so; cs = (float)co;
}

typedef _Float16 f16x4m __attribute__((ext_vector_type(4)));
__device__ __forceinline__ void norm_phase(const void* lat, bool lat16, const void* ctxp, bool ctx16, int nrows, const float* __restrict__ g, const float* __restrict__ modl, int k, bf16_t* A, int gw, int NGW, int lane, const _Float16* part, _Float16* ctx_out) {
    for (int row = gw; row < nrows; row += NGW) {
        const bool isctx = row >= ML; const size_t ro = (size_t)(isctx ? row - ML : row) * D + 4 * lane; const void* src = isctx ? ctxp : lat; const bool s16 = isctx ? ctx16 : lat16;
        const int bidx = isctx ? 16 : (row >> 11);
        const float* sh = modl + (size_t)bidx * 9216 + (3 * k) * 1024; const float* sc = sh + 1024;
        f32x4 v[4]; float ss = 0.f;
        if (s16) {
#pragma unroll
            for (int j = 0; j < 4; ++j) { const f16x4m hv = *(const f16x4m*)((const _Float16*)src + ro + 256 * j); v[j] = (f32x4){(float)hv[0], (float)hv[1], (float)hv[2], (float)hv[3]}; }
        } else {
#pragma unroll
            for (int j = 0; j < 4; ++j) v[j] = *(const f32x4*)((const float*)src + ro + 256 * j);
        }
        if (isctx && part != nullptr) {
#pragma unroll
            for (int j = 0; j < 4; ++j) { const f16x4m q0 = *(const f16x4m*)(part + ro + 256 * j), q1 = *(const f16x4m*)(part + (size_t)4096 * 1024 + ro + 256 * j), q2 = *(const f16x4m*)(part + (size_t)2 * 4096 * 1024 + ro + 256 * j), q3 = *(const f16x4m*)(part + (size_t)3 * 4096 * 1024 + ro + 256 * j);
                const f32x4 p0 = (f32x4){(float)q0[0], (float)q0[1], (float)q0[2], (float)q0[3]}, p1 = (f32x4){(float)q1[0], (float)q1[1], (float)q1[2], (float)q1[3]}, p2 = (f32x4){(float)q2[0], (float)q2[1], (float)q2[2], (float)q2[3]}, p3 = (f32x4){(float)q3[0], (float)q3[1], (float)q3[2], (float)q3[3]};
                v[j] = v[j] + ((p0 + p1) + (p2 + p3)); f16x4m ho; ho[0] = (_Float16)v[j][0]; ho[1] = (_Float16)v[j][1]; ho[2] = (_Float16)v[j][2]; ho[3] = (_Float16)v[j][3]; *(f16x4m*)(ctx_out + ro + 256 * j) = ho; } }
#pragma unroll
        for (int j = 0; j < 4; ++j) ss += (v[j].x * v[j].x + v[j].y * v[j].y) + (v[j].z * v[j].z + v[j].w * v[j].w);
        ss = wave_sum(ss, lane); const float r = 1.0f / sqrtf(ss * (1.0f / 1024.0f) + EPS);
#pragma unroll
        for (int j = 0; j < 4; ++j) { const int c = 4 * lane + 256 * j; const f32x4 gv = *(const f32x4*)(g + c), scv = *(const f32x4*)(sc + c), shv = *(const f32x4*)(sh + c);
            const f32x4 y = v[j] * r * gv * (scv + 1.0f) + shv;
            u32x2 w; w.x = pk_bf16(y.x, y.y); w.y = pk_bf16(y.z, y.w); *(u32x2*)(A + (size_t)row * D + c) = w; }
    }
}

__device__ __forceinline__ void head_nr64(int lane, bf16_t* hp, const u32x2 w1, const u32x2 w2, int sub, const float* __restrict__ g, bool rope, int t, const float* __restrict__ cs, const float* __restrict__ sn, float oscale, bool dostore) {
    float a[4] = {bflo(w1.x), bfhi(w1.x), bflo(w1.y), bfhi(w1.y)}, b[4] = {bflo(w2.x), bfhi(w2.x), bflo(w2.y), bfhi(w2.y)};
    float ss = 0.f;
#pragma unroll
    for (int e = 0; e < 4; ++e) ss += a[e] * a[e] + b[e] * b[e];
    ss += shx(ss, 1, lane); ss += shx(ss, 2, lane); ss += shx(ss, 4, lane);
    const float r = 1.0f / sqrtf(ss * (1.0f / 64.0f) + EPS);
    const f32x4 g1 = *(const f32x4*)(g + 4 * sub), g2 = *(const f32x4*)(g + 32 + 4 * sub);
#pragma unroll
    for (int e = 0; e < 4; ++e) { a[e] *= r * g1[e]; b[e] *= r * g2[e]; }
    if (rope) { const f32x4 c = *(const f32x4*)(cs + t * 32 + 4 * sub), s = *(const f32x4*)(sn + t * 32 + 4 * sub);
#pragma unroll
        for (int e = 0; e < 4; ++e) { const float na = a[e] * c[e] - b[e] * s[e], nb = a[e] * s[e] + b[e] * c[e]; a[e] = na; b[e] = nb; } }
#pragma unroll
    for (int e = 0; e < 4; ++e) { a[e] *= oscale; b[e] *= oscale; }
    if (dostore) { u32x2 o1, o2; o1.x = pk_bf16(a[0], a[1]); o1.y = pk_bf16(a[2], a[3]); o2.x = pk_bf16(b[0], b[1]); o2.y = pk_bf16(b[2], b[3]);
        *(u32x2*)(hp + 4 * sub) = o1; *(u32x2*)(hp + 32 + 4 * sub) = o2; }
}
__device__ __forceinline__ void head_nr96(int lane, const u32x4 wn, const unsigned wa, const unsigned wb, bf16_t* dst, int sub, const float* __restrict__ g, bool rope, int t, const float* __restrict__ cs, const float* __restrict__ sn, float oscale) {
    float n[8] = {bflo(wn.x), bfhi(wn.x), bflo(wn.y), bfhi(wn.y), bflo(wn.z), bfhi(wn.z), bflo(wn.w), bfhi(wn.w)};
    float a[2] = {bflo(wa), bfhi(wa)}, b[2] = {bflo(wb), bfhi(wb)};
    float ss = a[0] * a[0] + a[1] * a[1] + b[0] * b[0] + b[1] * b[1];
#pragma unroll
    for (int e = 0; e < 8; ++e) ss += n[e] * n[e];
    ss += shx(ss, 1, lane); ss += shx(ss, 2, lane); ss += shx(ss, 4, lane);
    const float r = 1.0f / sqrtf(ss * (1.0f / 96.0f) + EPS);
    const f32x4 ga = *(const f32x4*)(g + 8 * sub), gb = *(const f32x4*)(g + 8 * sub + 4);
#pragma unroll
    for (int e = 0; e < 4; ++e) { n[e] *= r * ga[e] * oscale; n[4 + e] *= r * gb[e] * oscale; }
#pragma unroll
    for (int e = 0; e < 2; ++e) { a[e] *= r * g[64 + 2 * sub + e]; b[e] *= r * g[80 + 2 * sub + e]; }
    if (rope) {
#pragma unroll
        for (int e = 0; e < 2; ++e) { const float c = cs[t * 16 + 2 * sub + e], s = sn[t * 16 + 2 * sub + e]; const float na = a[e] * c - b[e] * s, nb = a[e] * s + b[e] * c; a[e] = na; b[e] = nb; } }
    u32x4 o; o.x = pk_bf16(n[0], n[1]); o.y = pk_bf16(n[2], n[3]); o.z = pk_bf16(n[4], n[5]); o.w = pk_bf16(n[6], n[7]);
    *(u32x4*)(dst + 8 * sub) = o;
    *(unsigned*)(dst + 64 + 2 * sub) = pk_bf16(a[0] * oscale, a[1] * oscale); *(unsigned*)(dst + 80 + 2 * sub) = pk_bf16(b[0] * oscale, b[1] * oscale);
}

#define MFMA32(a, b, c) __builtin_amdgcn_mfma_f32_32x32x16_bf16((a), (b), (c), 0, 0, 0)
__device__ __forceinline__ int crow(int reg, int h) { return (reg & 3) + 8 * (reg >> 2) + 4 * h; }
__device__ __forceinline__ s16x4 vtr(const LAS unsigned char* p) { return __builtin_bit_cast(s16x4, __builtin_amdgcn_ds_read_tr16_b64_v4i16((LAS v4i16_t*)p)); }
__device__ __forceinline__ bf16x8 pack_step(const f32x16& x, int s) {
    u32x4 p; p.x = pk_bf16(x[8 * s + 0], x[8 * s + 1]); p.y = pk_bf16(x[8 * s + 2], x[8 * s + 3]); p.z = pk_bf16(x[8 * s + 4], x[8 * s + 5]); p.w = pk_bf16(x[8 * s + 6], x[8 * s + 7]);
    return __builtin_bit_cast(bf16x8, p);
}
template <int DQK, int DV, int KW, bool MASK>
__device__ __forceinline__ void attn_run(LAS unsigned char* lds, int tid, const bf16_t* __restrict__ Kg, int kpitch, const bf16_t* __restrict__ Vg, int vpitch,
                                         int ctx_row0, int lat_row0, int nt, const bf16x8 (&qf)[DQK / 16], int koffB, int qpos, int kpos0, bool late,
                                         f32x16 (&o)[DV / 32], float& m_out, float& l_out) {
    constexpr int KP = KW * 2 + 16, VP = DV * 2 + 64, KB = 64 * KP, VB = 64 * VP;
    constexpr int KCPR = KW / 8, VCPR = DV / 8, NKC = 64 * KCPR, NVC = 64 * VCPR, NKI = (NKC + 511) / 512, NVI = (NVC + 511) / 512;
    static_assert(2 * KB + 3 * VB <= 131072, "attention tiles fit");
    static_assert(NVC % 512 == 0, "V chunks");
    const int lane = tid & 63, r = lane & 31, h = lane >> 5;
    const int q4 = (lane & 15) >> 2, p4 = lane & 3, blk = (lane >> 4) & 1;
    unsigned vlane = (unsigned)((4 * h + q4) * VP + 32 * blk + 8 * p4), klane = (unsigned)(r * KP + koffB + h * 16); asm volatile("" : "+v"(vlane), "+v"(klane));
    unsigned kst[NKI], vst[NVI];
#pragma unroll
    for (int i_ = 0; i_ < NKI; ++i_) { const int c_ = tid + 512 * i_; kst[i_] = (unsigned)((c_ / KCPR) * KP + (c_ % KCPR) * 16); asm volatile("" : "+v"(kst[i_])); }
#pragma unroll
    for (int i_ = 0; i_ < NVI; ++i_) { const int c_ = tid + 512 * i_; vst[i_] = (unsigned)((c_ / VCPR) * VP + (c_ % VCPR) * 16); asm volatile("" : "+v"(vst[i_])); }
    u32x4 kregA[NKI], vregA[NVI];
#define ATT_GLOAD(t, KR, VR) do { const int tr_ = (t) < 4 ? ctx_row0 + 64 * (t) : lat_row0 + 64 * ((t) - 4); \
        _Pragma("unroll") for (int i_ = 0; i_ < NKI; ++i_) { const int c_ = tid + 512 * i_; if ((NKC % 512 == 0) || c_ < NKC) { const int rr_ = c_ / KCPR, cc_ = c_ % KCPR; KR[i_] = *(const u32x4*)(Kg + (size_t)(tr_ + rr_) * kpitch + cc_ * 8); } } \
        _Pragma("unroll") for (int i_ = 0; i_ < NVI; ++i_) { const int c_ = tid + 512 * i_; const int rr_ = c_ / VCPR, cc_ = c_ % VCPR; VR[i_] = *(const u32x4*)(Vg + (size_t)(tr_ + rr_) * vpitch + cc_ * 8); } } while (0)
#define ATT_LSTORE(kslot, vslot, KR, VR) do { LAS unsigned char* kb_ = lds + (kslot) * KB; LAS unsigned char* vb_ = lds + 2 * KB + (vslot) * VB; \
        _Pragma("unroll") for (int i_ = 0; i_ < NKI; ++i_) { const int c_ = tid + 512 * i_; if ((NKC % 512 == 0) || c_ < NKC) { *(LAS u32x4*)(kb_ + kst[i_]) = KR[i_]; } } \
        _Pragma("unroll") for (int i_ = 0; i_ < NVI; ++i_) { *(LAS u32x4*)(vb_ + vst[i_]) = VR[i_]; } } while (0)
#define ATT_SB() __builtin_amdgcn_sched_barrier(0)
#define ATT_BAR() do { asm volatile("s_waitcnt lgkmcnt(0)" ::: "memory"); __builtin_amdgcn_s_barrier(); asm volatile("" ::: "memory"); } while (0)
#define ATT_VLOAD(dst, vb_, c_) do { _Pragma("unroll") for (int e_ = 0; e_ < 2; ++e_) { const int g_ = (c_) / (DV / 64), db_ = 2 * ((c_) % (DV / 64)) + e_; \
            const LAS unsigned char* vp_ = (vb_) + ((32 * (g_ >> 1) + 16 * (g_ & 1)) * VP + 64 * db_); \
            const s16x4 lo_ = vtr(vp_), hi_ = vtr(vp_ + 8 * VP); dst[e_] = __builtin_shufflevector(lo_, hi_, 0, 1, 2, 3, 4, 5, 6, 7); } } while (0)
#define ATT_PVM(src, c_) do { _Pragma("unroll") for (int e_ = 0; e_ < 2; ++e_) { const int g_ = (c_) / (DV / 64), db_ = 2 * ((c_) % (DV / 64)) + e_; o[db_] = MFMA32(src[e_], pw[g_], o[db_]); } } while (0)
#define ATT_PV(vbase) do { const LAS unsigned char* vbp_ = (vbase); bf16x8 va_[2], vc_[2]; constexpr int NC_ = 4 * (DV / 64); \
        ATT_VLOAD(va_, vbp_, 0); ATT_SB(); \
        _Pragma("unroll") for (int c2_ = 0; c2_ < NC_; c2_ += 2) { \
            ATT_VLOAD(vc_, vbp_, c2_ + 1); ATT_SB(); ATT_PVM(va_, c2_); ATT_SB(); \
            if (c2_ + 2 < NC_) { ATT_VLOAD(va_, vbp_, c2_ + 2); } ATT_SB(); ATT_PVM(vc_, c2_ + 1); ATT_SB(); } } while (0)
    ATT_GLOAD(0, kregA, vregA); ATT_LSTORE(0, 0, kregA, vregA);
    ATT_BAR();
    float m = 0.f, l = 0.f; f32x16 negm; { float z_ = 0.f; asm volatile("" : "+v"(z_));
#pragma unroll
    for (int i = 0; i < 16; ++i) negm[i] = z_; }
    bf16x8 pw[4];
#pragma unroll
    for (int i = 0; i < 4; ++i) pw[i] = (bf16x8){0, 0, 0, 0, 0, 0, 0, 0};
    int vcur = 0, vprev = 0;
    for (int t2 = 0; t2 < nt; t2 += 2) {
#pragma unroll
    for (int par = 0; par < 2; ++par) { const int t = t2 + par; if (t < nt) {
        const int vnext = (vcur == 2) ? 0 : vcur + 1;
        if (t + 1 < nt) ATT_GLOAD(t + 1, kregA, vregA);
        const LAS unsigned char* kb = lds + (t & 1) * KB + klane;
        bf16x8 kf[2 * (DQK / 16)];
#pragma unroll
        for (int d0 = 0; d0 < DQK / 16; ++d0) {
            kf[2 * d0] = *(const LAS bf16x8*)(kb + d0 * 32);
            kf[2 * d0 + 1] = *(const LAS bf16x8*)(kb + 32 * KP + d0 * 32);
        }
        ATT_SB();
        if (late && t > 0) ATT_PV(lds + 2 * KB + vprev * VB + vlane);
        f32x16 s0 = negm, s1 = negm;
#pragma unroll
        for (int d0 = 0; d0 < DQK / 16; ++d0) { s0 = MFMA32(kf[2 * d0], qf[d0], s0); s1 = MFMA32(kf[2 * d0 + 1], qf[d0], s1); }
        ATT_SB();
        if (MASK) { if (t >= 4) { const int dq = kpos0 + 64 * (t - 4) - qpos;
#pragma unroll
            for (int i = 0; i < 16; ++i) { const int d0_ = dq + crow(i, h); if (d0_ > 128 || d0_ < -128) s0[i] = -INFINITY; const int d1_ = d0_ + 32; if (d1_ > 128 || d1_ < -128) s1[i] = -INFINITY; } } }
        float mt = __builtin_fmaxf(s0[0], s1[0]), mu = __builtin_fmaxf(s0[1], s1[1]);
#pragma unroll
        for (int i = 2; i < 16; i += 2) { mt = __builtin_fmaxf(__builtin_fmaxf(mt, s0[i]), s1[i]); mu = __builtin_fmaxf(__builtin_fmaxf(mu, s0[i + 1]), s1[i + 1]); }
        mt = __builtin_fmaxf(mt, mu);
        { auto rr = __builtin_amdgcn_permlane32_swap(__float_as_uint(mt), __float_as_uint(mt), false, false); mt = fmaxf(__uint_as_float(rr[0]), __uint_as_float(rr[1])); }
        constexpr float THR = 4.0f;
        if (t == 0 || __builtin_amdgcn_ballot_w64(mt > THR) != 0ull) {
            const float delta = (t == 0) ? mt : __builtin_fmaxf(mt, 0.f);
            if (t != 0) { const float alpha = __builtin_amdgcn_exp2f(-delta); l *= alpha;
#pragma unroll
                for (int db = 0; db < DV / 32; ++db)
#pragma unroll
                    for (int i = 0; i < 16; ++i) o[db][i] *= alpha; }
            m += delta;
#pragma unroll
            for (int i = 0; i < 16; ++i) { s0[i] -= delta; s1[i] -= delta; negm[i] = -m; }
            asm volatile("" : "+v"(negm));
        }
        float ps = 0.f;
#pragma unroll
        for (int i = 0; i < 16; ++i) { s0[i] = __builtin_amdgcn_exp2f(s0[i]); s1[i] = __builtin_amdgcn_exp2f(s1[i]); ps += s0[i] + s1[i]; }
        l += ps;
        pw[0] = pack_step(s0, 0); pw[1] = pack_step(s0, 1); pw[2] = pack_step(s1, 0); pw[3] = pack_step(s1, 1);
        if (!late) ATT_PV(lds + 2 * KB + vcur * VB + vlane);
        if (t + 1 < nt) ATT_LSTORE((t + 1) & 1, vnext, kregA, vregA);
        vprev = vcur; vcur = vnext;
        ATT_BAR();
    } } }
    if (late) ATT_PV(lds + 2 * KB + vprev * VB + vlane);
    ATT_BAR();
    m_out = m; l_out = l;
#undef ATT_GLOAD
#undef ATT_LSTORE
#undef ATT_PV
#undef ATT_PVM
#undef ATT_VLOAD
#undef ATT_SB
#undef ATT_BAR
}

template <int DQK, int DV, int KW, bool MASK>
__device__ __forceinline__ void attn_run2(LAS unsigned char* lds, int tid, const bf16_t* __restrict__ Kg, int kpitch, const bf16_t* __restrict__ Vg, int vpitch,
                                          int ctx_row0, int lat_row0, int nt, const bf16x8 (&qf)[DQK / 16], int koffB, int qpos, int kpos0,
                                          f32x16 (&o)[DV / 32], float& m_out, float& l_out) {
    constexpr int KP = KW * 2 + 16, VP = DV * 2 + 64, KB = 64 * KP, VB = 64 * VP, ND = DQK / 16;
    constexpr int KCPR = KW / 8, VCPR = DV / 8, NKC = 64 * KCPR, NVC = 64 * VCPR, NKI = (NKC + 511) / 512, NVI = (NVC + 511) / 512;
    static_assert(2 * KB + 3 * VB <= 131072 && NVC % 512 == 0 && ND % 2 == 0, "attention tiles");
    const int lane = tid & 63, r = lane & 31, h = lane >> 5;
    const int q4 = (lane & 15) >> 2, p4 = lane & 3, blk = (lane >> 4) & 1;
    u32x4 kregA[NKI], vregA[NVI], kregB[NKI], vregB[NVI];
#define A2_GLOAD(t, KR, VR) do { const int tr_ = (t) < 4 ? ctx_row0 + 64 * (t) : lat_row0 + 64 * ((t) - 4); \
        _Pragma("unroll") for (int i_ = 0; i_ < NKI; ++i_) { const int c_ = tid + 512 * i_; if ((NKC % 512 == 0) || c_ < NKC) { const int rr_ = c_ / KCPR, cc_ = c_ % KCPR; KR[i_] = *(const u32x4*)(Kg + (size_t)(tr_ + rr_) * kpitch + cc_ * 8); } } \
        _Pragma("unroll") for (int i_ = 0; i_ < NVI; ++i_) { const int c_ = tid + 512 * i_; const int rr_ = c_ / VCPR, cc_ = c_ % VCPR; VR[i_] = *(const u32x4*)(Vg + (size_t)(tr_ + rr_) * vpitch + cc_ * 8); } } while (0)
#define A2_LSTORE(kslot, vslot, KR, VR) do { LAS unsigned char* kb_ = lds + (kslot) * KB; LAS unsigned char* vb_ = lds + 2 * KB + (vslot) * VB; \
        _Pragma("unroll") for (int i_ = 0; i_ < NKI; ++i_) { const int c_ = tid + 512 * i_; if ((NKC % 512 == 0) || c_ < NKC) { const int rr_ = c_ / KCPR, cc_ = c_ % KCPR; *(LAS u32x4*)(kb_ + rr_ * KP + cc_ * 16) = KR[i_]; } } \
        _Pragma("unroll") for (int i_ = 0; i_ < NVI; ++i_) { const int c_ = tid + 512 * i_; const int rr_ = c_ / VCPR, cc_ = c_ % VCPR; *(LAS u32x4*)(vb_ + rr_ * VP + cc_ * 16) = VR[i_]; } } while (0)
#define A2_SB() __builtin_amdgcn_sched_barrier(0)
#define A2_KFRAG(kb_, d0_, half_) (*(const LAS bf16x8*)((kb_) + ((half_) * 32 + r) * KP + koffB + (d0_) * 32 + h * 16))
#define A2_EL(P0, P1, e_) (((e_) < 16) ? P0[(e_) & 15] : P1[(e_) & 15])
#define A2_FILLA(P0, P1, j_) do { if ((j_) < 8) { const int e_ = 4 * (j_); \
        sacc += (A2_EL(P0, P1, e_) + A2_EL(P0, P1, e_ + 1)) + (A2_EL(P0, P1, e_ + 2) + A2_EL(P0, P1, e_ + 3)); \
        pw[((j_) >> 2) * 2 + (((j_) & 3) >> 1)][2 * ((j_) & 1)] = pk_bf16(A2_EL(P0, P1, e_), A2_EL(P0, P1, e_ + 1)); \
        pw[((j_) >> 2) * 2 + (((j_) & 3) >> 1)][2 * ((j_) & 1) + 1] = pk_bf16(A2_EL(P0, P1, e_ + 2), A2_EL(P0, P1, e_ + 3)); } } while (0)
#define A2_QK(S0, S1, kb_, FILL, P0, P1) do { bf16x8 ka_[2], kc_[2]; \
        ka_[0] = A2_KFRAG(kb_, 0, 0); ka_[1] = A2_KFRAG(kb_, 0, 1); A2_SB(); \
        _Pragma("unroll") for (int d_ = 0; d_ < ND; d_ += 2) { \
            kc_[0] = A2_KFRAG(kb_, d_ + 1, 0); kc_[1] = A2_KFRAG(kb_, d_ + 1, 1); A2_SB(); \
            S0 = MFMA32(ka_[0], qf[d_], S0); if (FILL) A2_FILLA(P0, P1, 2 * d_); A2_SB(); \
            S1 = MFMA32(ka_[1], qf[d_], S1); if (FILL) A2_FILLA(P0, P1, 2 * d_ + 1); A2_SB(); \
            if (d_ + 2 < ND) { ka_[0] = A2_KFRAG(kb_, d_ + 2, 0); ka_[1] = A2_KFRAG(kb_, d_ + 2, 1); } A2_SB(); \
            S0 = MFMA32(kc_[0], qf[d_ + 1], S0); if (FILL) A2_FILLA(P0, P1, 2 * d_ + 2); A2_SB(); \
            S1 = MFMA32(kc_[1], qf[d_ + 1], S1); if (FILL) A2_FILLA(P0, P1, 2 * d_ + 3); A2_SB(); } } while (0)
#define A2_VLOAD(dst, vb_, c_) do { _Pragma("unroll") for (int e_ = 0; e_ < 2; ++e_) { const int g_ = (c_) / (DV / 64), db_ = 2 * ((c_) % (DV / 64)) + e_; \
            const LAS unsigned char* vp_ = (vb_) + (32 * (g_ >> 1) + 16 * (g_ & 1) + 4 * h + q4) * VP + (32 * db_ + 16 * blk) * 2 + 8 * p4; \
            const s16x4 lo_ = vtr(vp_), hi_ = vtr(vp_ + 8 * VP); dst[e_] = __builtin_shufflevector(lo_, hi_, 0, 1, 2, 3, 4, 5, 6, 7); } } while (0)
#define A2_FILLB(S0, S1, gap_) do { constexpr int EPG_ = 32 / (8 * (DV / 64)); _Pragma("unroll") for (int i_ = 0; i_ < EPG_; ++i_) { const int e_ = (gap_) * EPG_ + i_; \
        if (e_ < 16) S0[e_ & 15] = __builtin_amdgcn_exp2f(S0[e_ & 15] - m); else S1[e_ & 15] = __builtin_amdgcn_exp2f(S1[e_ & 15] - m); } } while (0)
#define A2_PVM1(src, c_, e_) do { const int g_ = (c_) / (DV / 64), db_ = 2 * ((c_) % (DV / 64)) + (e_); o[db_] = MFMA32(src[e_], __builtin_bit_cast(bf16x8, pw[g_]), o[db_]); } while (0)
#define A2_PV(vbase, S0, S1, DOEXP) do { const LAS unsigned char* vbp_ = (vbase); bf16x8 va_[2], vc_[2]; constexpr int NC_ = 4 * (DV / 64); \
        A2_VLOAD(va_, vbp_, 0); A2_SB(); \
        _Pragma("unroll") for (int c2_ = 0; c2_ < NC_; c2_ += 2) { \
            A2_VLOAD(vc_, vbp_, c2_ + 1); A2_SB(); \
            A2_PVM1(va_, c2_, 0); if (DOEXP) A2_FILLB(S0, S1, 2 * c2_); A2_SB(); \
            A2_PVM1(va_, c2_, 1); if (DOEXP) A2_FILLB(S0, S1, 2 * c2_ + 1); A2_SB(); \
            if (c2_ + 2 < NC_) { A2_VLOAD(va_, vbp_, c2_ + 2); } A2_SB(); \
            A2_PVM1(vc_, c2_ + 1, 0); if (DOEXP) A2_FILLB(S0, S1, 2 * c2_ + 2); A2_SB(); \
            A2_PVM1(vc_, c2_ + 1, 1); if (DOEXP) A2_FILLB(S0, S1, 2 * c2_ + 3); A2_SB(); } } while (0)
#define A2_ZERO(S0, S1) do { _Pragma("unroll") for (int i_ = 0; i_ < 16; ++i_) { S0[i_] = 0.f; S1[i_] = 0.f; } } while (0)
#define A2_MASK(S0, S1, t_) do { if (MASK) { if ((t_) >= 4) { const int dq_ = kpos0 + 64 * ((t_) - 4) - qpos; \
        _Pragma("unroll") for (int i_ = 0; i_ < 16; ++i_) { const int d0_ = dq_ + crow(i_, h); if (d0_ > 128 || d0_ < -128) S0[i_] = -INFINITY; const int d1_ = d0_ + 32; if (d1_ > 128 || d1_ < -128) S1[i_] = -INFINITY; } } } } while (0)
#define A2_ROWMAX(S0, S1, mt_) do { mt_ = fmaxf(S0[0], S1[0]); _Pragma("unroll") for (int i_ = 1; i_ < 16; ++i_) mt_ = fmaxf(mt_, fmaxf(S0[i_], S1[i_])); \
        auto rr_ = __builtin_amdgcn_permlane32_swap(__float_as_uint(mt_), __float_as_uint(mt_), false, false); mt_ = fmaxf(__uint_as_float(rr_[0]), __uint_as_float(rr_[1])); } while (0)
#define A2_BAR() do { asm volatile("s_waitcnt lgkmcnt(0)" ::: "memory"); __builtin_amdgcn_s_barrier(); asm volatile("" ::: "memory"); } while (0)
#define A2_STEP(t_, S0, S1, P0, P1, KRL, VRL, KRS, VRS) do { \
        const int vnext_ = (vcur == 2) ? 0 : vcur + 1; \
        if ((t_) + 2 < nt) A2_GLOAD((t_) + 2, KRL, VRL); \
        const LAS unsigned char* kbs_ = lds + ((t_) & 1) * KB; \
        float sacc = 0.f; A2_ZERO(S0, S1); \
        A2_QK(S0, S1, kbs_, true, P0, P1); \
        l += sacc; \
        A2_MASK(S0, S1, t_); \
        float mt_; A2_ROWMAX(S0, S1, mt_); \
        const float mn_ = fmaxf(m, mt_); const bool resc_ = __builtin_amdgcn_ballot_w64(mn_ > m) != 0ull; float alpha_ = 1.0f; \
        if (resc_) { alpha_ = __builtin_amdgcn_exp2f(m - mn_); l *= alpha_; m = mn_; } \
        A2_PV(lds + 2 * KB + vprev * VB, S0, S1, true); \
        if (resc_) { _Pragma("unroll") for (int db_ = 0; db_ < DV / 32; ++db_) _Pragma("unroll") for (int i_ = 0; i_ < 16; ++i_) o[db_][i_] *= alpha_; } \
        if ((t_) + 1 < nt) A2_LSTORE(((t_) + 1) & 1, vnext_, KRS, VRS); \
        vprev = vcur; vcur = vnext_; \
        A2_BAR(); } while (0)
    f32x16 sA0, sA1, sB0, sB1; u32x4 pw[4]; float m, l = 0.f;
    int vcur = 0, vprev = 0;
    A2_GLOAD(0, kregA, vregA); A2_LSTORE(0, 0, kregA, vregA);
    if (1 < nt) A2_GLOAD(1, kregB, vregB);
    A2_BAR();
    {
        if (2 < nt) A2_GLOAD(2, kregA, vregA);
        A2_ZERO(sA0, sA1); float sacc = 0.f;
        A2_QK(sA0, sA1, lds, false, sA0, sA1); (void)sacc;
        A2_MASK(sA0, sA1, 0);
        float mt_; A2_ROWMAX(sA0, sA1, mt_); m = mt_;
#pragma unroll
        for (int i = 0; i < 16; ++i) { sA0[i] = __builtin_amdgcn_exp2f(sA0[i] - m); sA1[i] = __builtin_amdgcn_exp2f(sA1[i] - m); }
        if (1 < nt) A2_LSTORE(1, 1, kregB, vregB);
        vprev = 0; vcur = 1;
        A2_BAR();
    }
    for (int t2 = 1; t2 < nt; t2 += 2) {
        A2_STEP(t2, sB0, sB1, sA0, sA1, kregB, vregB, kregA, vregA);
        if (t2 + 1 < nt) A2_STEP(t2 + 1, sA0, sA1, sB0, sB1, kregA, vregA, kregB, vregB);
    }
    {
        float sacc = 0.f;
        if ((nt - 1) & 1) {
#pragma unroll
            for (int j = 0; j < 8; ++j) A2_FILLA(sB0, sB1, j);
        } else {
#pragma unroll
            for (int j = 0; j < 8; ++j) A2_FILLA(sA0, sA1, j);
        }
        l += sacc;
        A2_PV(lds + 2 * KB + vprev * VB, sA0, sA1, false);
    }
    __syncthreads();
    m_out = m; l_out = l;
#undef A2_GLOAD
#undef A2_LSTORE
#undef A2_SB
#undef A2_KFRAG
#undef A2_EL
#undef A2_FILLA
#undef A2_QK
#undef A2_VLOAD
#undef A2_FILLB
#undef A2_PVM1
#undef A2_PV
#undef A2_ZERO
#undef A2_MASK
#undef A2_ROWMAX
#undef A2_STEP
#undef A2_BAR
}
template <int NDB>
__device__ __forceinline__ void write_o(int lane, const f32x16 (&o)[NDB], float l, float m, bool sink, float sinkv, bf16_t* obase, int hh, LAS unsigned char* stg) {
    float lt = l + shx(l, 32, lane); if (sink) lt += __builtin_amdgcn_exp2f(sinkv - m);
    const float inv = 1.0f / lt;
    constexpr int RB = NDB * 64 + 16, CPR = NDB * 4;
    LAS unsigned char* wp = stg + (lane & 31) * RB + 8 * hh;
#pragma unroll
    for (int db = 0; db < NDB; ++db)
#pragma unroll
        for (int g = 0; g < 4; ++g) { u32x2 w; w.x = pk_bf16(o[db][4 * g] * inv, o[db][4 * g + 1] * inv); w.y = pk_bf16(o[db][4 * g + 2] * inv, o[db][4 * g + 3] * inv);
            *(LAS u32x2*)(wp + 64 * db + 16 * g) = w; }
    asm volatile("s_waitcnt lgkmcnt(0)" ::: "memory");
#pragma unroll
    for (int i = 0; i < 32 * CPR / 64; ++i) { const int c = i * 64 + lane, row = c / CPR, ch = c % CPR;
        const u32x4 v = *(const LAS u32x4*)(stg + row * RB + ch * 16); *(u32x4*)(obase + (size_t)row * 1024 + ch * 8) = v; }
    asm volatile("s_waitcnt lgkmcnt(0)" ::: "memory");
}

#define XB_TMO      128
#define XB_XCNT(j)  (256  + 64 * (j))
#define XB_XSUB(j)  (1280 + 64 * (j))
#define XB_XGEN(j)  (2304 + 64 * (j))
#define XB_TOP      3328
#define XB_TOPGEN   3392
#define XCD_BAR_WORDS 3456
#define XB_SPIN_CAP (1u << 18)
__device__ __forceinline__ unsigned xb_ld(unsigned* p)              { return __hip_atomic_load(p, __ATOMIC_RELAXED, __HIP_MEMORY_SCOPE_AGENT); }
__device__ __forceinline__ unsigned xb_add(unsigned* p, unsigned v) { return __hip_atomic_fetch_add(p, v, __ATOMIC_RELAXED, __HIP_MEMORY_SCOPE_AGENT); }
__device__ __forceinline__ unsigned xb_xcc_id() { return (unsigned)__builtin_amdgcn_s_getreg((3 << 11) | 20) & 0xFu; }
#define XB_SPIN(cond, bar) do { unsigned _sp = 0; while (cond) { __builtin_amdgcn_s_sleep(1); \
    if ((++_sp & 255u) == 0u) { if (xb_ld(&(bar)[XB_TMO])) break; if (_sp > XB_SPIN_CAP) { atomicAdd(&(bar)[XB_TMO], 1u); break; } } } } while (0)
__device__ __forceinline__ void xcd_barrier_complete(unsigned* bar, unsigned x, unsigned& nloc, unsigned& nx) {
    const unsigned G = gridDim.x * gridDim.y * gridDim.z;
    unsigned sum, cnt, mine, sp = 0u;
    for (;;) {
        sum = 0u; cnt = 0u; mine = 0u;
#pragma unroll
        for (unsigned j = 0; j < 16; ++j) { const unsigned c = xb_ld(&bar[XB_XCNT(j)]); sum += c; cnt += (c > 0u) ? 1u : 0u; mine = (j == x) ? c : mine; }
        if (sum == G) break;
        __builtin_amdgcn_s_sleep(1);
        if ((++sp & 255u) == 0u) { if (xb_ld(&bar[XB_TMO])) break; if (sp > XB_SPIN_CAP) { atomicAdd(&bar[XB_TMO], 1u); break; } }
    }
    nloc = mine > 0u ? mine : 1u; nx = cnt > 0u ? cnt : 1u;
}
__device__ __forceinline__ void xcd_barrier(unsigned* bar, volatile LAS unsigned* st, int tid) {
    asm volatile("s_waitcnt vmcnt(0)" ::: "memory");
    __syncthreads();
    if (tid == 0) {
        const unsigned x = xb_xcc_id();
        __builtin_amdgcn_s_waitcnt(0);
        unsigned nloc = st[0], nx = st[1];
        if (nloc == 0u) { xcd_barrier_complete(bar, x, nloc, nx); st[0] = nloc; st[1] = nx; }
        const unsigned old = xb_add(&bar[XB_XSUB(x)], 1u);
        const unsigned gen = old / nloc;
        if (old + 1u == (gen + 1u) * nloc) {
            __builtin_amdgcn_fence(__ATOMIC_RELEASE, "agent");
            asm volatile("s_waitcnt vmcnt(0)" ::: "memory");
            const unsigned og = xb_add(&bar[XB_TOP], 1u);
            const unsigned tg = og / nx;
            if (og + 1u == (tg + 1u) * nx) xb_add(&bar[XB_TOPGEN], 1u);
            else XB_SPIN(xb_ld(&bar[XB_TOPGEN]) == tg, bar);
            __builtin_amdgcn_fence(__ATOMIC_ACQUIRE, "agent");
            xb_add(&bar[XB_XGEN(x)], 1u);
            asm volatile("s_waitcnt vmcnt(0)" ::: "memory");
        } else {
            XB_SPIN(xb_ld(&bar[XB_XGEN(x)]) == gen, bar);
            __builtin_amdgcn_fence(__ATOMIC_ACQUIRE, "agent");
            asm volatile("s_waitcnt vmcnt(0)" ::: "memory");
        }
    }
    __syncthreads();
}

struct Args { const float* in[36]; float* out; unsigned char* ws; };

__global__ void __attribute__((amdgpu_flat_work_group_size(512, 512), amdgpu_waves_per_eu(2, 2))) fwd_megakernel(Args a) {
    extern __shared__ __attribute__((aligned(16))) unsigned char lds_raw[];
    LAS unsigned char* lds = (LAS unsigned char*)lds_raw;
    const int wave0 = __builtin_amdgcn_readfirstlane((int)threadIdx.x >> 6);
    typedef const __attribute__((address_space(4))) unsigned char* kptr_t;
    const int G = gridDim.x, bid = blockIdx.x, NGW = G * 8;
#define PHASE_IDS() int tid; asm volatile("v_mbcnt_lo_u32_b32 %0, -1, 0\n\tv_mbcnt_hi_u32_b32 %0, -1, %0" : "=v"(tid)); tid += wave0 * 64; const int lane = tid & 63; const int wave = __builtin_amdgcn_readfirstlane(tid >> 6); const int gw = bid * 8 + wave; (void)lane; (void)wave; (void)gw; \
    kptr_t ka_ = (kptr_t)__builtin_amdgcn_kernarg_segment_ptr(); asm volatile("" : "+s"(ka_)); \
    unsigned char* ws = *(unsigned char* const __attribute__((address_space(4)))*)(ka_ + 37 * 8); float* OUT = *(float* const __attribute__((address_space(4)))*)(ka_ + 36 * 8); \
    float* modtab = (float*)(ws + WS_MOD); float* cos64 = (float*)(ws + WS_ROPE); float* sin64 = cos64 + 2048 * 32; float* cos32 = sin64 + 2048 * 32; float* sin32 = cos32 + 2048 * 16; \
    float* HC = (float*)(ws + WS_HC); bf16_t* W = (bf16_t*)(ws + WS_W); bf16_t* A = (bf16_t*)OUT; _Float16* HL = (_Float16*)(ws + WS_HL); _Float16* HCh = (_Float16*)(ws + WS_HCH); (void)HL; (void)HCh; bf16_t* U = (bf16_t*)(ws + WS_P); bf16_t* P1 = U; bf16_t* P0 = U; \
    bf16_t* Qf = (bf16_t*)(ws + WS_QF); bf16_t* KVf = (bf16_t*)(ws + WS_KVF); bf16_t* MK = (bf16_t*)(ws + WS_MK); \
    const float* modl = modtab + (size_t)l * 17 * 9216; const float* ng = l ? IN(23) : IN(6); \
    (void)modtab; (void)cos64; (void)sin64; (void)cos32; (void)sin32; (void)HC; (void)W; (void)A; (void)U; (void)P1; (void)P0; (void)Qf; (void)KVf; (void)MK; (void)OUT; (void)modl; (void)ng
#define IN(i) (*(const float* const __attribute__((address_space(4)))*)(ka_ + 8 * (i)))
#define PHASE_IDS0() const int l = 0; PHASE_IDS()
#define GRID_BAR() do { int tb_; asm volatile("v_mbcnt_lo_u32_b32 %0, -1, 0\n\tv_mbcnt_hi_u32_b32 %0, -1, %0" : "=v"(tb_)); tb_ += wave0 * 64; \
    kptr_t kb_ = (kptr_t)__builtin_amdgcn_kernarg_segment_ptr(); asm volatile("" : "+s"(kb_)); unsigned char* wsb_ = *(unsigned char* const __attribute__((address_space(4)))*)(kb_ + 37 * 8); \
    xcd_barrier((unsigned*)(wsb_ + WS_BAR), (volatile LAS unsigned*)(lds + 131072 + 512), tb_); } while (0)

    {
        const int l = 0; PHASE_IDS();
        if (tid < 2) ((volatile LAS unsigned*)(lds + 131072 + 512))[tid] = 0u;
        if (bid == 0) { unsigned* bar = (unsigned*)(ws + WS_BAR); for (int i = tid; i < XCD_BAR_WORDS; i += 512) __hip_atomic_store(&bar[i], 0u, __ATOMIC_RELAXED, __HIP_MEMORY_SCOPE_AGENT); }
        for (int i = bid * 512 + tid; i < 2048 * 32 + 2048 * 16; i += G * 512) {
            if (i < 2048 * 32) { const int t = i >> 5, f = i & 31; const float inv = exp2f(-(float)(f & 15) * (13.287712379549449f / 16.0f)); const float pos = (f < 16) ? (float)(t >> 6) : (float)(t & 63);
                const float ang = pos * inv; float sn, cs; sincos_d((double)ang, sn, cs); cos64[i] = cs; sin64[i] = sn; }
            else { const int j = i - 2048 * 32; const int t = j >> 4, f = j & 15; const float inv = exp2f(-(float)(f & 7) * (13.287712379549449f / 8.0f)); const float pos = (f < 8) ? (float)(t >> 6) : (float)(t & 63);
                const float ang = pos * inv; float sn, cs; sincos_d((double)ang, sn, cs); cos32[j] = cs; sin32[j] = sn; }
        }
        for (int i = bid * 512 + tid; i < 96 * 1024 / 8; i += G * 512) *(u32x4*)(W + WO_WIN0 + (size_t)1184 * 1024 + (size_t)i * 8) = (u32x4){0u, 0u, 0u, 0u};
        if (bid < 288) {
            LAS float* sc = (LAS float*)lds;
            LAS float* part = sc + 17 * 1024;
            for (int i = tid; i < 17 * 1024; i += 512) { const float v = i < 16 * 1024 ? IN(1)[i] : IN(3)[i - 16 * 1024]; sc[i] = v / (1.0f + expf(-v)); }
            __syncthreads();
            for (int task = bid; task < 288; task += G) {
                const int l = task / 144, gq = task % 144, j = gq * 64 + lane;
                const float* aw = l ? IN(21) : IN(4); const float* ab = l ? IN(22) : IN(5);
                float acc[17];
#pragma unroll
                for (int b = 0; b < 17; ++b) acc[b] = 0.f;
                const int kbeg = wave * 128;
#pragma unroll 4
                for (int k = kbeg; k < kbeg + 128; ++k) { const float w = aw[(size_t)k * 9216 + j];
#pragma unroll
                    for (int b = 0; b < 17; ++b) acc[b] += sc[b * 1024 + k] * w; }
#pragma unroll
                for (int b = 0; b < 17; ++b) part[(wave * 17 + b) * 64 + lane] = acc[b];
                __syncthreads();
                for (int o = tid; o < 17 * 64; o += 512) { const int b = o >> 6, ln = o & 63; float s = 0.f;
#pragma unroll
                    for (int w = 0; w < 8; ++w) s += part[(w * 17 + b) * 64 + ln];
                    modtab[(size_t)(l * 17 + b) * 9216 + gq * 64 + ln] = s + ab[gq * 64 + ln]; }
                __syncthreads();
            }
        }
        __syncthreads();
        LAS float* scr = (LAS float*)(lds + wave * 16384);
        constexpr int IT_G = 16 * 88, IT_D = 44 * 32, IT_WIN0 = 16 * 37, IT_WQB = 4 * 24, IT_WKVB = 2 * 32, IT_WOUT = 16 * 32, IT_WIN1 = 16 * 96;
        constexpr int NITEMS = 8 * IT_G + 4 * IT_D + IT_WIN0 + IT_WQB + IT_WKVB + 2 * IT_WOUT + IT_WIN1;
        for (int it = gw; it < NITEMS; it += NGW) {
            int r = it;
            if (r < 8 * IT_G) { const int mi = r / IT_G; r -= mi * IT_G; const int l = mi >> 2, s = (mi >> 1) & 1, gu = mi & 1;
                const float* src = (l ? (gu ? IN(25) : IN(24)) : (gu ? IN(8) : IN(7))) + (size_t)s * 1024 * 2816;
                conv_item(src, 1024, 2816, W + WO_GU + (size_t)(l * 2 + s) * SZ_GU, 1 + gu, scr, r, lane); continue; }
            r -= 8 * IT_G;
            if (r < 4 * IT_D) { const int mi = r / IT_D; r -= mi * IT_D; const int l = mi >> 1, s = mi & 1;
                const float* src = (l ? IN(26) : IN(9)) + (size_t)s * 2816 * 1024;
                conv_item(src, 2816, 1024, W + WO_WD + (size_t)(l * 2 + s) * SZ_WD, 0, scr, r, lane); continue; }
            r -= 4 * IT_D;
            if (r < IT_WIN0) { conv_item(IN(10), 1024, 1184, W + WO_WIN0, 0, scr, r, lane); continue; } r -= IT_WIN0;
            if (r < IT_WQB) { conv_item(IN(12), 256, 768, W + WO_WQB, 0, scr, r, lane); continue; } r -= IT_WQB;
            if (r < IT_WKVB) { conv_item(IN(14), 128, 1024, W + WO_WKVB, 0, scr, r, lane); continue; } r -= IT_WKVB;
            if (r < IT_WOUT) { conv_item(IN(20), 1024, 1024, W + WO_WOUT0, 0, scr, r, lane); continue; } r -= IT_WOUT;
            if (r < IT_WIN1) { conv_item(IN(27), 1024, 3072, W + WO_WIN1, 3, scr, r, lane); continue; } r -= IT_WIN1;
            conv_item(IN(35), 1024, 1024, W + WO_WOUT1, 0, scr, r, lane);
        }
    }
    cg::this_grid().sync();
    { PHASE_IDS0(); if (tid == 0) (void)xb_add((unsigned*)(ws + WS_BAR) + XB_XCNT(xb_xcc_id()), 1u); }

#pragma nounroll
    for (int step = 0; step < 4; ++step) {
        const int l = step >> 1, s = step & 1;

        if (s == 1) {
            { PHASE_IDS(); norm_phase(HL, true, l ? (const void*)HCh : (const void*)IN(2), l != 0, MT, ng + 1024, modl, 1, A, gw, NGW, lane, (const _Float16*)(ws + WS_PART), HCh); }
            GRID_BAR();
            if (l == 0) {   PHASE_IDS();
                pg8::Gemm g{A, W + WO_WIN0, MT, P0W, 1024, 1024}; pg8::StaticOrder S; S.init(MT, P0W, G, bid);
                pg8::EpiStoreBf16 E{P0, P0P};
                pg8::gemm_phase<pg8::EpiStoreBf16, pg8::StaticOrder, true, true>(lds, g, S, E, tid);
            } else {        PHASE_IDS();
                pg8::Gemm g{A, W + WO_WIN1, MT, P1W, 1024, 1024}; pg8::StaticOrder S; S.init(MT, P1W, G, bid);
                pg8::EpiQKV1 E{P1, P1P, IN(28), IN(29), cos64, sin64, ML / 256, 0.125f * LOG2E, EPS};
                pg8::gemm_phase<pg8::EpiQKV1, pg8::StaticOrder, true, true>(lds, g, S, E, tid);
            }
            GRID_BAR();
            if (l == 0) {
                { PHASE_IDS();
                for (int row = gw; row < MT; row += NGW) {
                    bf16_t* p = P0 + (size_t)row * P0P; const bool lat = row < ML; const int t = row & 2047; const int sub = lane & 7;
                    bf16_t* hq = p + 416 + (lane >> 3) * 64; bf16_t* hk = p + 928 + ((lane >> 3) & 1) * 64;
                    const u32x2 w = *(const u32x2*)(p + 4 * lane); const unsigned wv = *(const unsigned*)(p + 256 + 2 * lane);
                    const u32x2 q1 = *(const u32x2*)(hq + 4 * sub), q2 = *(const u32x2*)(hq + 32 + 4 * sub), k1 = *(const u32x2*)(hk + 4 * sub), k2 = *(const u32x2*)(hk + 32 + 4 * sub);
                    { const float x0 = bflo(w.x), x1 = bfhi(w.x), x2 = bflo(w.y), x3 = bfhi(w.y);
                      const float ss = wave_sum((x0 * x0 + x1 * x1) + (x2 * x2 + x3 * x3), lane); const float r = 1.0f / sqrtf(ss * (1.0f / 256.0f) + EPS); const f32x4 gq = *(const f32x4*)(IN(11) + 4 * lane);
                      u32x2 o; o.x = pk_bf16(x0 * r * gq.x, x1 * r * gq.y); o.y = pk_bf16(x2 * r * gq.z, x3 * r * gq.w); *(u32x2*)(p + 4 * lane) = o; }
                    { const float x0 = bflo(wv), x1 = bfhi(wv);
                      const float ss = wave_sum(x0 * x0 + x1 * x1, lane); const float r = 1.0f / sqrtf(ss * (1.0f / 128.0f) + EPS);
                      *(unsigned*)(p + 256 + 2 * lane) = pk_bf16(x0 * r * IN(13)[2 * lane], x1 * r * IN(13)[2 * lane + 1]); }
                    head_nr64(lane, hq, q1, q2, sub, IN(17), lat, t, cos64, sin64, 0.125f * LOG2E, true);
                    head_nr64(lane, hk, k1, k2, sub, IN(18), lat, t, cos64, sin64, 1.0f, lane < 16);
                } }
                GRID_BAR();
                {   PHASE_IDS(); pg8::Gemm g{P0, W + WO_WQB, MT, 768, 256, P0P}; pg8::StaticOrder S; S.init(MT, 768, G, bid);
                    pg8::EpiStoreBf16 E{Qf, 768};
                    pg8::gemm_phase<pg8::EpiStoreBf16, pg8::StaticOrder, true, true>(lds, g, S, E, tid); }
                {   PHASE_IDS(); pg8::Gemm g{P0 + 256, W + WO_WKVB, MT, 1024, 128, P0P}; pg8::StaticOrder S; S.init(MT, 1024, G, bid);
                    pg8::EpiStoreBf16 E{KVf, KVP};
                    pg8::gemm_phase<pg8::EpiStoreBf16, pg8::StaticOrder, true, true>(lds, g, S, E, tid); }
                GRID_BAR();
                { PHASE_IDS();
                for (int row = gw; row < MT; row += NGW) {
                    const bool lat = row < ML; const int t = row & 2047; const int hd = lane >> 3, sub = lane & 7;
                    bf16_t* qp = Qf + (size_t)row * 768 + hd * 96; const bf16_t* kvp = KVf + (size_t)row * KVP + hd * 128; const bf16_t* krp = P0 + (size_t)row * P0P + 384;
                    const u32x4 wnq = *(const u32x4*)(qp + 8 * sub); const unsigned waq = *(const unsigned*)(qp + 64 + 2 * sub), wbq = *(const unsigned*)(qp + 80 + 2 * sub);
                    const u32x4 wnk = *(const u32x4*)(kvp + 8 * sub); const unsigned wak = *(const unsigned*)(krp + 2 * sub), wbk = *(const unsigned*)(krp + 16 + 2 * sub);
                    head_nr96(lane, wnq, waq, wbq, qp, sub, IN(15), lat, t, cos32, sin32, 0.10206207261596575f * LOG2E);
                    head_nr96(lane, wnk, wak, wbk, MK + (size_t)row * MKP + hd * 96, sub, IN(16), lat, t, cos32, sin32, 1.0f);
                } }
                GRID_BAR();
                { PHASE_IDS();
                for (int rep_ = 0; rep_ < REP_ATT0; ++rep_)
                for (int u = ((G & 7) == 0 ? (bid & 7) * (G >> 3) + (bid >> 3) : bid); u < 1024 + 128 + 1152; u += G) {

                    const int r = lane & 31, hh = lane >> 5;
                    if (u < 1024 + 128) {
                        int b, h, qrow0, nt;
                        if (u < 1024) { b = u >> 6; h = (u >> 3) & 7; qrow0 = b * 2048 + 256 * (u & 7); nt = 36; }
                        else { const int v = u - 1024; b = v >> 3; h = v & 7; qrow0 = ML + b * 256; nt = 4; }
                        const int qrow = qrow0 + 32 * wave + r;
                        bf16x8 qf[6];
#pragma unroll
                        for (int d0 = 0; d0 < 6; ++d0) qf[d0] = *(const bf16x8*)(Qf + (size_t)qrow * 768 + h * 96 + 16 * d0 + 8 * hh);
                        f32x16 o[2];
#pragma unroll
                        for (int i = 0; i < 16; ++i) { o[0][i] = 0.f; o[1][i] = 0.f; }
                        float m, lsum;
                        attn_run<96, 64, 96, false>(lds, tid, MK + h * 96, MKP, KVf + h * 128 + 64, KVP, ML + b * 256, b * 2048, nt, qf, 0, 0, 0, false, o, m, lsum);
                        write_o<2>(lane, o, lsum, m, false, 0.f, A + (size_t)(qrow - r) * 1024 + h * 64, hh, lds + 65536 + wave * 4608);
                    } else {
                        const int v = u - 1152; const int b = v / 72, kvh = (v / 36) & 1, qb = v % 36;
                        const bool isctx = qb < 4; const int q0l = isctx ? 0 : 64 * (qb - 4);
                        const int hq = kvh * 4 + (wave >> 1), qloc = 32 * (wave & 1) + r;
                        const int qrow = (isctx ? ML + b * 256 + 64 * qb : b * 2048 + q0l) + qloc;
                        int lat0 = 0, nt = 4;
                        if (!isctx) { lat0 = q0l - 128 > 0 ? q0l - 128 : 0; const int last = q0l + 192 < 2048 ? q0l + 192 : 2048; nt = 4 + (last - lat0) / 64; }
                        bf16x8 qf[4];
#pragma unroll
                        for (int d0 = 0; d0 < 4; ++d0) qf[d0] = *(const bf16x8*)(P0 + (size_t)qrow * P0P + 416 + hq * 64 + 16 * d0 + 8 * hh);
                        f32x16 o[2];
#pragma unroll
                        for (int i = 0; i < 16; ++i) { o[0][i] = 0.f; o[1][i] = 0.f; }
                        float m, lsum;
                        attn_run<64, 64, 64, true>(lds, tid, P0 + 928 + kvh * 64, P0P, P0 + 1056 + kvh * 64, P0P, ML + b * 256, b * 2048 + lat0, nt, qf, 0, q0l + qloc, lat0, false, o, m, lsum);
                        write_o<2>(lane, o, lsum, m, true, IN(19)[hq] * LOG2E, A + (size_t)(qrow - r) * 1024 + 512 + hq * 64, hh, lds + 65536 + wave * 4608);
                    }
                } }
            } else {
                { PHASE_IDS();
                const float lam = __expf(wave_sum(IN(30)[lane] * IN(31)[lane], lane)) - __expf(wave_sum(IN(32)[lane] * IN(33)[lane], lane)) + LAMBDA_INIT;
                for (int rep_ = 0; rep_ < REP_ATT1; ++rep_)
                for (int u = ((G & 7) == 0 ? (bid & 7) * (G >> 3) + (bid >> 3) : bid); u < 2048; u += G) {

                    const int r = lane & 31, hh = lane >> 5;
                    const int b = u >> 7, h = (u >> 4) & 7, qb = u & 15, mm = wave >> 2;
                    const int qrow = b * 2048 + 128 * qb + 32 * (wave & 3) + r;
                    bf16x8 qf[4];
#pragma unroll
                    for (int d0 = 0; d0 < 4; ++d0) qf[d0] = *(const bf16x8*)(P1 + (size_t)qrow * P1P + h * 128 + mm * 64 + 16 * d0 + 8 * hh);
                    f32x16 o[4];
#pragma unroll
                    for (int db = 0; db < 4; ++db)
#pragma unroll
                        for (int i = 0; i < 16; ++i) o[db][i] = 0.f;
                    float m, lsum;
                    attn_run<64, 128, 128, false>(lds, tid, P1 + 1024 + h * 128, P1P, P1 + 2048 + h * 128, P1P, ML + b * 256, b * 2048, 36, qf, mm * 128, 0, 0, false, o, m, lsum);
                    const float inv = 1.0f / (lsum + shx(lsum, 32, lane));
                    LAS float* stage = (LAS float*)lds + ((wave & 3) * 64) * 64 + lane;
                    asm volatile("" : "+v"(stage));
                    if (mm == 1) {
#pragma unroll
                        for (int db = 0; db < 4; ++db)
#pragma unroll
                            for (int i = 0; i < 16; ++i) stage[(db * 16 + i) * 64] = o[db][i] * inv;
                    }
                    __syncthreads();
                    if (mm == 0) {
                        float ss = 0.f;
#pragma unroll
                        for (int db = 0; db < 4; ++db)
#pragma unroll
                            for (int i = 0; i < 16; ++i) { const float x = o[db][i] * inv - lam * stage[(db * 16 + i) * 64]; o[db][i] = x; ss += x * x; }
                        ss += shx(ss, 32, lane);
                        const float rr = (1.0f - LAMBDA_INIT) / sqrtf(ss * (1.0f / 128.0f) + EPS);
                        LAS unsigned char* stg = lds + 96256 + wave * 8704;
                        LAS unsigned char* wp = stg + r * 272 + 8 * hh;
#pragma unroll
                        for (int db = 0; db < 4; ++db)
#pragma unroll
                            for (int g4 = 0; g4 < 4; ++g4) { const int d = 32 * db + 8 * g4 + 4 * hh; const f32x4 sg = *(const f32x4*)(IN(34) + d);
                                u32x2 w; w.x = pk_bf16(o[db][4 * g4] * rr * sg.x, o[db][4 * g4 + 1] * rr * sg.y); w.y = pk_bf16(o[db][4 * g4 + 2] * rr * sg.z, o[db][4 * g4 + 3] * rr * sg.w);
                                *(LAS u32x2*)(wp + 64 * db + 16 * g4) = w; }
                        asm volatile("s_waitcnt lgkmcnt(0)" ::: "memory");
                        bf16_t* obase = A + (size_t)(qrow - r) * 1024 + h * 128;
#pragma unroll
                        for (int i = 0; i < 8; ++i) { const int c = i * 64 + lane, row = c >> 4, ch = c & 15;
                            const u32x4 v = *(const LAS u32x4*)(stg + row * 272 + ch * 16); *(u32x4*)(obase + (size_t)row * 1024 + ch * 8) = v; }
                        asm volatile("s_waitcnt lgkmcnt(0)" ::: "memory");
                    }
                    __syncthreads();
                } }
            }
            GRID_BAR();
            {   PHASE_IDS();
                const int M = l ? ML : MT;
                pg8::Gemm g{A, W + (l ? WO_WOUT1 : WO_WOUT0), M, 1024, 1024, 1024}; pg8::SplitCtxOrder S; S.init(ML, 1024, G, bid, 16, l == 0);
                pg8::EpiResidPart<true, true> E{HL, HL, (_Float16*)(ws + WS_PART), modl + 5 * 1024, 1.0f, ML / 256};
                pg8::gemm_phase<pg8::EpiResidPart<true, true>, pg8::SplitCtxOrder, true, true>(lds, g, S, E, tid);
            }
            GRID_BAR();
        }
        const int Mf = (step == 3) ? ML : MT;
        {
#define NLNC() const void* nl = (step == 0) ? (const void*)IN(0) : (const void*)HL; const void* nc = (step == 0) ? (const void*)IN(2) : (const void*)HCh
            for (int rep_ = 0; rep_ < REP_NORM; ++rep_) { PHASE_IDS(); NLNC(); norm_phase(nl, step != 0, nc, step != 0, Mf, ng + (s ? 2048 : 0), modl, s ? 2 : 0, A, gw, NGW, lane, (step == 1 || step == 2) ? (const _Float16*)(ws + WS_PART) : (const _Float16*)nullptr, HCh); }
            GRID_BAR();
            {   PHASE_IDS(); pg8::Gemm g{A, W + WO_GU + (size_t)step * SZ_GU, Mf, 5632, 1024, 1024}; pg8::StaticOrder S; S.init(Mf, 5632, G, bid);
                pg8::EpiSwiglu E{U, DFF};
                for (int rep_ = 0; rep_ < REP_GU; ++rep_) pg8::gemm_phase<pg8::EpiSwiglu, pg8::StaticOrder, true, true>(lds, g, S, E, tid); }
            GRID_BAR();
            {   PHASE_IDS(); NLNC(); pg8::Gemm g{U, W + WO_WD + (size_t)step * SZ_WD, Mf, 1024, DFF, DFF}; pg8::SplitCtxOrder S; S.init(ML, 1024, G, bid, DFF / 64, step < 3);
                (void)nc; _Float16* partp = (_Float16*)(ws + WS_PART); const float* gatep = modl + (s ? 8 : 2) * 1024;
                if (step == 0) { pg8::EpiResidPart<false, true> E{nl, HL, partp, gatep, 0.5f, ML / 256}; pg8::gemm_phase<pg8::EpiResidPart<false, true>, pg8::SplitCtxOrder, true, true>(lds, g, S, E, tid); }
                else if (step == 3) { pg8::EpiResidPart<true, false> E{nl, OUT, partp, gatep, 0.5f, ML / 256}; pg8::gemm_phase<pg8::EpiResidPart<true, false>, pg8::SplitCtxOrder, true, true>(lds, g, S, E, tid); }
                else { pg8::EpiResidPart<true, true> E{nl, HL, partp, gatep, 0.5f, ML / 256}; pg8::gemm_phase<pg8::EpiResidPart<true, true>, pg8::SplitCtxOrder, true, true>(lds, g, S, E, tid); } }
            if (step < 3) GRID_BAR();
            for (int rep_ = 0; rep_ < REP_SYNC; ++rep_) GRID_BAR();
        }
    }
#undef IN
}

extern "C" void kernel_launch(void* const* d_in, const int* in_sizes, int n_in, void* d_out, int out_size, void* d_ws, size_t ws_size, hipStream_t stream) {
    static int grid_blocks = 0;
    if (grid_blocks == 0) {
        if (n_in != 36 || ws_size < WS_END) { fprintf(stderr, "kernel_launch: unexpected n_in %d / ws_size %zu\n", n_in, ws_size); grid_blocks = -1; return; }
        int dev = 0, cus = 0, per_cu = 0;
        hipGetDevice(&dev);
        hipDeviceGetAttribute(&cus, hipDeviceAttributeMultiprocessorCount, dev);
        hipFuncSetAttribute((const void*)fwd_megakernel, hipFuncAttributeMaxDynamicSharedMemorySize, LDS_BYTES);
        hipOccupancyMaxActiveBlocksPerMultiprocessor(&per_cu, (const void*)fwd_megakernel, 512, LDS_BYTES);
        if (per_cu < 1) per_cu = 1;
        grid_blocks = cus * per_cu;
        (void)hipGetLastError();
    }
    if (grid_blocks < 0) return;
    Args a{};
    for (int i = 0; i < 36; ++i) a.in[i] = (const float*)d_in[i];
    a.out = (float*)d_out; a.ws = (unsigned char*)d_ws;
    void* args[] = {&a};
    hipError_t e = hipLaunchCooperativeKernel((const void*)fwd_megakernel, dim3(grid_blocks), dim3(512), args, LDS_BYTES, stream);
    if (e != hipSuccess) fprintf(stderr, "cooperative launch failed: %s (grid %d)\n", hipGetErrorString(e), grid_blocks);
}
```

```cpp
#include <hip/hip_runtime.h>
#include <hip/hip_cooperative_groups.h>
#include <cstdio>
#include <cstdint>
namespace cg = cooperative_groups;
namespace pg8 {
#define PG8_LAS __attribute__((address_space(3)))
typedef unsigned short bf16_t;
typedef short bf16x8 __attribute__((ext_vector_type(8)));
typedef float f32x4 __attribute__((ext_vector_type(4)));
typedef unsigned u32x4 __attribute__((ext_vector_type(4)));
constexpr int BM = 256, BK = 64, HALF = 128, HTB = HALF * BK * 2  , STAGE_BYTES = 8 * HTB, NXCD = 8, WGM = 8;

__host__ __device__ __forceinline__ int lds_byte(int r, int c) { const int st = (r >> 4) * 2 + (c >> 5), rr = r & 15, cc = c & 31, ob = rr * 64 + cc * 2; return st * 1024 + (ob ^ (((ob >> 9) & 1) << 5)); }
__host__ __device__ __forceinline__ void stage_rc(int b, int& R, int& C) { const int st = b / 1024, sb = b % 1024, swz = sb ^ (((sb >> 9) & 1) << 5); R = (st >> 1) * 16 + swz / 64; C = (st & 1) * 32 + (swz % 64) / 2; }
__host__ __device__ __forceinline__ int perm32(int rho) { const int n = rho >> 4, i = rho & 15; return 8 * (i >> 2) + 4 * n + (i & 3); }

struct Unit { int pm, pn, kinfo; };
struct Gemm { const bf16_t* A; const bf16_t* Bt; int M, N, K, lda; };

struct StaticOrder {
    int nM, nN, nwg, G, c;
    __host__ __device__ void init(int M, int N, int G_, int c_) { nM = M / BM; nN = N / BM; nwg = nM * nN; G = G_; c = c_; }
    __host__ __device__ bool next(int i, Unit& u) const {
        const long L = (long)i * G + c; if (L >= nwg) return false;
        int wgid = (int)L; { const int q = nwg / NXCD, r = nwg % NXCD, xcd = wgid % NXCD, off = wgid / NXCD; wgid = (xcd < r ? xcd * (q + 1) : r * (q + 1) + (xcd - r) * q) + off; }
        const int nig = WGM * nN, gid = wgid / nig, fm = gid * WGM, gsz = (nM - fm) < WGM ? (nM - fm) : WGM;
        u.pm = fm + ((wgid % nig) % gsz); u.pn = (wgid % nig) / gsz; u.kinfo = 0; return true;
    }
    __device__ __forceinline__ void a_ready(const Unit&) const {}
    __device__ __forceinline__ void done(const Unit&) const {}
};


struct SplitCtxOrder {
    StaticOrder lat; int nmine, nN_, G_, c_, nkA, nkB, nparts;
    __host__ __device__ void init(int Mlat, int N, int G, int c, int ntK, bool with_ctx) { lat.init(Mlat, N, G, c); nmine = c < lat.nwg ? (lat.nwg - c + G - 1) / G : 0; nN_ = N / BM; G_ = G; c_ = c;
        nkA = ((ntK / 4 + 1) / 2) * 2; nkB = (ntK - 2 * nkA) / 2; nparts = with_ctx ? 16 * nN_ * 4 : 0; }
    __host__ __device__ bool next(int i, Unit& u) const {
        if (i < nmine) return lat.next(i, u);
        const int idx = (i - nmine) * G_ + c_; if (idx >= nparts) return false;
        const int kp = idx & 3, tile = idx >> 2;
        u.pm = lat.nM + tile / nN_; u.pn = tile % nN_;
        const int k0 = kp < 2 ? kp * nkA : 2 * nkA + (kp - 2) * nkB, nk = kp < 2 ? nkA : nkB; u.kinfo = k0 | (nk << 8) | (kp << 16); return true;
    }
    __device__ __forceinline__ void a_ready(const Unit&) const {}
    __device__ __forceinline__ void done(const Unit&) const {}
};
__device__ __forceinline__ unsigned cvt_pk_bf16(float lo, float hi) { unsigned r; asm volatile("v_cvt_pk_bf16_f32 %0, %1, %2" : "=v"(r) : "v"(lo), "v"(hi)); return r; }
typedef float f32x2 __attribute__((ext_vector_type(2)));
__device__ __forceinline__ unsigned pk_bf16(float lo, float hi) { typedef __bf16 b2_t __attribute__((ext_vector_type(2))); f32x2 v = {lo, hi}; b2_t b = __builtin_convertvector(v, b2_t); return __builtin_bit_cast(unsigned, b); }
__device__ __forceinline__ float silu_f(float x) { return x * __builtin_amdgcn_rcpf(1.0f + __builtin_amdgcn_exp2f(-1.4426950408889634f * x)); }

struct EpiStoreBf16 {
    static constexpr bool PERM = true, AFTER_DRAIN = false;
    bf16_t* O; int ldc;
    __device__ __forceinline__ void operator()(const f32x4 (&acc)[2][2][4][2], const Unit& u, int wr, int wc, int fr, int fq) const {
        const int row0 = u.pm * BM + wr * 64 + fr, col0 = u.pn * BM + wc * 32 + 8 * fq;
#pragma unroll
        for (int ai = 0; ai < 2; ++ai)
#pragma unroll
            for (int m = 0; m < 4; ++m) { bf16_t* rowp = O + (size_t)(row0 + ai * HALF + m * 16) * ldc + col0;
#pragma unroll
                for (int bj = 0; bj < 2; ++bj) { const f32x4 v0 = acc[ai][bj][m][0], v1 = acc[ai][bj][m][1];
                    u32x4 w; w.x = pk_bf16(v0[0], v0[1]); w.y = pk_bf16(v0[2], v0[3]); w.z = pk_bf16(v1[0], v1[1]); w.w = pk_bf16(v1[2], v1[3]);
                    *(u32x4*)(rowp + bj * HALF) = w; } }
    }
};
struct EpiSwiglu {
    static constexpr bool PERM = true, AFTER_DRAIN = false;
    bf16_t* U; int ldu;
    __device__ __forceinline__ void operator()(const f32x4 (&acc)[2][2][4][2], const Unit& u, int wr, int wc, int fr, int fq) const {
        const int row0 = u.pm * BM + wr * 64 + fr, col0 = u.pn * HALF + wc * 32 + 8 * fq;
#pragma unroll
        for (int ai = 0; ai < 2; ++ai)
#pragma unroll
            for (int m = 0; m < 4; ++m) { bf16_t* rowp = U + (size_t)(row0 + ai * HALF + m * 16) * ldu + col0;
                const f32x4 g0 = acc[ai][0][m][0], g1 = acc[ai][0][m][1], u0 = acc[ai][1][m][0], u1 = acc[ai][1][m][1];
                u32x4 w;
                w.x = pk_bf16(silu_f(g0[0]) * u0[0], silu_f(g0[1]) * u0[1]); w.y = pk_bf16(silu_f(g0[2]) * u0[2], silu_f(g0[3]) * u0[3]);
                w.z = pk_bf16(silu_f(g1[0]) * u1[0], silu_f(g1[1]) * u1[1]); w.w = pk_bf16(silu_f(g1[2]) * u1[2], silu_f(g1[3]) * u1[3]);
                *(u32x4*)rowp = w; }
    }
};
struct EpiResid {
    static constexpr bool PERM = false, AFTER_DRAIN = false;
    const float* base_lat; const float* base_ctx; float* out_lat; float* out_ctx; const float* gate; float gs;
    __device__ __forceinline__ void operator()(const f32x4 (&acc)[2][2][4][2], const Unit& u, int wr, int wc, int fr, int fq) const {
        const bool isctx = u.pm >= 128; const int bidx = isctx ? 16 : (u.pm >> 3);
        const float* base = isctx ? base_ctx : base_lat; float* out = isctx ? out_ctx : out_lat;
        const int rloc = (isctx ? (u.pm - 128) : u.pm) * BM + wr * 64 + fr, col0 = u.pn * BM + wc * 32 + 4 * fq;
        f32x4 gv[2][2];
#pragma unroll
        for (int bj = 0; bj < 2; ++bj)
#pragma unroll
            for (int n = 0; n < 2; ++n) gv[bj][n] = *(const f32x4*)(gate + (size_t)bidx * 9216 + col0 + bj * HALF + n * 16) * gs;
#pragma unroll
        for (int ai = 0; ai < 2; ++ai)
#pragma unroll
            for (int m = 0; m < 4; ++m) { const size_t off = (size_t)(rloc + ai * HALF + m * 16) * 1024 + col0;
#pragma unroll
                for (int bj = 0; bj < 2; ++bj)
#pragma unroll
                    for (int n = 0; n < 2; ++n) { const f32x4 b = *(const f32x4*)(base + off + bj * HALF + n * 16);
                        *(f32x4*)(out + off + bj * HALF + n * 16) = b + gv[bj][n] * acc[ai][bj][m][n]; } }
    }
};

typedef _Float16 f16x8 __attribute__((ext_vector_type(8)));
typedef _Float16 f16x4 __attribute__((ext_vector_type(4)));
template <bool BASE16, bool OUT16> struct EpiResidPart {
    static constexpr bool PERM = true, AFTER_DRAIN = false;
    const void* base_lat; void* out_lat; _Float16* part; const float* gate; float gs; int nMlat;
    __device__ __forceinline__ void operator()(const f32x4 (&acc)[2][2][4][2], const Unit& u, int wr, int wc, int fr, int fq) const {
        const bool isctx = u.pm >= nMlat; const int bidx = isctx ? 16 : (u.pm >> 3);
        const int rloc = (isctx ? (u.pm - nMlat) : u.pm) * BM + wr * 64 + fr, col0 = u.pn * BM + wc * 32 + 8 * fq;
        f32x4 gv[2][2];
#pragma unroll
        for (int bj = 0; bj < 2; ++bj)
#pragma unroll
            for (int n = 0; n < 2; ++n) gv[bj][n] = *(const f32x4*)(gate + (size_t)bidx * 9216 + col0 + bj * HALF + n * 4) * gs;
        if (!isctx) {
#pragma unroll
            for (int ai = 0; ai < 2; ++ai) {
                f32x4 pre[4][2][2];
#pragma unroll
                for (int m = 0; m < 4; ++m) { const size_t off = (size_t)(rloc + ai * HALF + m * 16) * 1024 + col0;
#pragma unroll
                    for (int bj = 0; bj < 2; ++bj) {
                        if (BASE16) { const f16x8 hb = *(const f16x8*)((const _Float16*)base_lat + off + bj * HALF);
                            pre[m][bj][0] = (f32x4){(float)hb[0], (float)hb[1], (float)hb[2], (float)hb[3]}; pre[m][bj][1] = (f32x4){(float)hb[4], (float)hb[5], (float)hb[6], (float)hb[7]}; }
                        else { pre[m][bj][0] = *(const f32x4*)((const float*)base_lat + off + bj * HALF); pre[m][bj][1] = *(const f32x4*)((const float*)base_lat + off + bj * HALF + 4); } } }
                asm volatile("" ::: "memory");
#pragma unroll
                for (int m = 0; m < 4; ++m) { const size_t off = (size_t)(rloc + ai * HALF + m * 16) * 1024 + col0;
#pragma unroll
                    for (int bj = 0; bj < 2; ++bj) { const f32x4 o0 = pre[m][bj][0] + gv[bj][0] * acc[ai][bj][m][0], o1 = pre[m][bj][1] + gv[bj][1] * acc[ai][bj][m][1];
                        if (OUT16) { f16x8 ho; ho[0] = (_Float16)o0[0]; ho[1] = (_Float16)o0[1]; ho[2] = (_Float16)o0[2]; ho[3] = (_Float16)o0[3]; ho[4] = (_Float16)o1[0]; ho[5] = (_Float16)o1[1]; ho[6] = (_Float16)o1[2]; ho[7] = (_Float16)o1[3];
                            *(f16x8*)((_Float16*)out_lat + off + bj * HALF) = ho; }
                        else { *(f32x4*)((float*)out_lat + off + bj * HALF) = o0; *(f32x4*)((float*)out_lat + off + bj * HALF + 4) = o1; } } }
                asm volatile("" ::: "memory");
            }
        } else {
            _Float16* pp = part + (size_t)(u.kinfo >> 16) * (4096 * 1024);
#pragma unroll
            for (int ai = 0; ai < 2; ++ai)
#pragma unroll
                for (int m = 0; m < 4; ++m) { const size_t off = (size_t)(rloc + ai * HALF + m * 16) * 1024 + col0;
#pragma unroll
                    for (int bj = 0; bj < 2; ++bj) { const f32x4 p0 = gv[bj][0] * acc[ai][bj][m][0], p1 = gv[bj][1] * acc[ai][bj][m][1];
                        f16x8 hp; hp[0] = (_Float16)p0[0]; hp[1] = (_Float16)p0[1]; hp[2] = (_Float16)p0[2]; hp[3] = (_Float16)p0[3]; hp[4] = (_Float16)p1[0]; hp[5] = (_Float16)p1[1]; hp[6] = (_Float16)p1[2]; hp[7] = (_Float16)p1[3];
                        *(f16x8*)(pp + off + bj * HALF) = hp; } }
        }
    }
};

struct EpiQKV1 {
    static constexpr bool PERM = true, AFTER_DRAIN = false;
    bf16_t* P; int ldp; const float* qg; const float* kg; const float* cs; const float* sn; int nMlat; float qscale, eps;
    __device__ __forceinline__ void operator()(const f32x4 (&acc)[2][2][4][2], const Unit& u, int wr, int wc, int fr, int fq) const {
        const int row0 = u.pm * BM + wr * 64 + fr, colb = u.pn * BM + wc * 64 + 8 * fq;
        if (u.pn >= 8) {
#pragma unroll
            for (int ai = 0; ai < 2; ++ai)
#pragma unroll
                for (int m = 0; m < 4; ++m) { bf16_t* rowp = P + (size_t)(row0 + ai * HALF + m * 16) * ldp + colb;
#pragma unroll
                    for (int bj = 0; bj < 2; ++bj) { const f32x4 v0 = acc[ai][bj][m][0], v1 = acc[ai][bj][m][1];
                        u32x4 w; w.x = pk_bf16(v0[0], v0[1]); w.y = pk_bf16(v0[2], v0[3]); w.z = pk_bf16(v1[0], v1[1]); w.w = pk_bf16(v1[2], v1[3]);
                        *(u32x4*)(rowp + 32 * bj) = w; } }
            return;
        }
        const bool isq = u.pn < 4, lat = u.pm < nMlat; const float* g = isq ? qg : kg; const float osc = isq ? qscale : 1.0f;
        f32x4 g1[2], g2[2];
#pragma unroll
        for (int n = 0; n < 2; ++n) { g1[n] = *(const f32x4*)(g + 8 * fq + 4 * n) * osc; g2[n] = *(const f32x4*)(g + 32 + 8 * fq + 4 * n) * osc; }
        const int lane = fq * 16 + fr;
#pragma unroll
        for (int ai = 0; ai < 2; ++ai)
#pragma unroll
            for (int m = 0; m < 4; ++m) { const int row = row0 + ai * HALF + m * 16;
                const f32x4 a0 = acc[ai][0][m][0], a1 = acc[ai][0][m][1], b0 = acc[ai][1][m][0], b1 = acc[ai][1][m][1];
                float ss = ((a0[0] * a0[0] + a0[1] * a0[1]) + (a0[2] * a0[2] + a0[3] * a0[3])) + ((a1[0] * a1[0] + a1[1] * a1[1]) + (a1[2] * a1[2] + a1[3] * a1[3]))
                         + ((b0[0] * b0[0] + b0[1] * b0[1]) + (b0[2] * b0[2] + b0[3] * b0[3])) + ((b1[0] * b1[0] + b1[1] * b1[1]) + (b1[2] * b1[2] + b1[3] * b1[3]));
                ss += __int_as_float(__builtin_amdgcn_ds_bpermute((lane ^ 16) << 2, __float_as_int(ss)));
                ss += __int_as_float(__builtin_amdgcn_ds_bpermute((lane ^ 32) << 2, __float_as_int(ss)));
                const float r = 1.0f / sqrtf(ss * (1.0f / 64.0f) + eps);
                f32x4 y10 = a0 * r * g1[0], y11 = a1 * r * g1[1], y20 = b0 * r * g2[0], y21 = b1 * r * g2[1];
                if (lat) { const int t = row & 2047;
                    const f32x4 c0 = *(const f32x4*)(cs + t * 32 + 8 * fq), c1 = *(const f32x4*)(cs + t * 32 + 8 * fq + 4), s0 = *(const f32x4*)(sn + t * 32 + 8 * fq), s1 = *(const f32x4*)(sn + t * 32 + 8 * fq + 4);
                    const f32x4 o10 = y10 * c0 - y20 * s0, o20 = y10 * s0 + y20 * c0, o11 = y11 * c1 - y21 * s1, o21 = y11 * s1 + y21 * c1;
                    y10 = o10; y20 = o20; y11 = o11; y21 = o21; }
                bf16_t* rowp = P + (size_t)row * ldp + colb;
                u32x4 w1; w1.x = pk_bf16(y10[0], y10[1]); w1.y = pk_bf16(y10[2], y10[3]); w1.z = pk_bf16(y11[0], y11[1]); w1.w = pk_bf16(y11[2], y11[3]);
                u32x4 w2; w2.x = pk_bf16(y20[0], y20[1]); w2.y = pk_bf16(y20[2], y20[3]); w2.z = pk_bf16(y21[0], y21[1]); w2.w = pk_bf16(y21[2], y21[3]);
                *(u32x4*)(rowp) = w1; *(u32x4*)(rowp + 32) = w2; }
    }
};

template <class Epi, class Sched, bool ALIGN_EPI = false, bool SP2 = false>
__device__ __forceinline__ void gemm_phase(PG8_LAS unsigned char* lds, const Gemm g, const Sched& S, const Epi& E, int tid_in) {
    const int tid = tid_in, wid = __builtin_amdgcn_readfirstlane(tid >> 6), lane = tid & 63, wr = wid >> 2, wc = wid & 3, fr = lane & 15, fq = lane >> 4;
    const int K = g.K, nt = K / BK;
    unsigned voffA[2], voffB[2];
#pragma unroll
    for (int i = 0; i < 2; ++i) { int R, C; stage_rc(tid * 16 + i * 8192, R, C); const int Rb = Epi::PERM ? ((R & ~31) + perm32(R & 31)) : R;
        voffA[i] = (unsigned)(R * g.lda + C) * 2u; voffB[i] = (unsigned)(Rb * K + C) * 2u; }
    const size_t kstep = (size_t)(BK * 2);
    const size_t hstepB = (size_t)HALF * K * 2, hstepA = (size_t)HALF * g.lda * 2;
    const size_t tstepA = 2 * hstepA, tstepB = 2 * hstepB;
    const unsigned ldsw = (unsigned)wid * 1024u;
    const int aoff = lds_byte(wr * 64 + fr, fq * 8), boff = lds_byte(wc * 32 + fr, fq * 8);
#define PG8_SA(b, h) (((b) * 2 + (h)) * HTB)
#define PG8_SB(b, h) ((4 + (b) * 2 + (h)) * HTB)
#define PG8_STAGE(bufoff, gbase, voff) do { _Pragma("unroll") for (int _i = 0; _i < 2; ++_i) \
        __builtin_amdgcn_global_load_lds((const unsigned*)((const char*)(gbase) + (voff)[_i]), (PG8_LAS unsigned*)(lds + (bufoff) + ldsw + _i * 8192), 16, 0, 0); } while (0)
#define PG8_LDA(dst, b, h) do { _Pragma("unroll") for (int m = 0; m < 4; ++m) _Pragma("unroll") for (int k = 0; k < 2; ++k) dst[m][k] = *(const PG8_LAS bf16x8*)(lds + PG8_SA(b, h) + aoff + m * 2048 + k * 1024); } while (0)
#define PG8_LDB(dst, b, h) do { _Pragma("unroll") for (int n = 0; n < 2; ++n) _Pragma("unroll") for (int k = 0; k < 2; ++k) dst[n][k] = *(const PG8_LAS bf16x8*)(lds + PG8_SB(b, h) + boff + n * 2048 + k * 1024); } while (0)
#define PG8_MMA(ai, bj, At, Bt) do { __builtin_amdgcn_s_setprio(1); _Pragma("unroll") for (int m = 0; m < 4; ++m) _Pragma("unroll") for (int n = 0; n < 2; ++n) _Pragma("unroll") for (int k = 0; k < 2; ++k) \
        acc[ai][bj][m][n] = __builtin_amdgcn_mfma_f32_16x16x32_bf16(Bt[n][k], At[m][k], acc[ai][bj][m][n], 0, 0, 0); __builtin_amdgcn_s_setprio(0); } while (0)
#define PG8_WAIT_V(n) asm volatile("s_waitcnt vmcnt(" #n ")" ::: "memory")
#define PG8_WAIT_L(n) asm volatile("s_waitcnt lgkmcnt(" #n ")" ::: "memory")
#define PG8_BAR __builtin_amdgcn_s_barrier()
#define PG8_SCHED __builtin_amdgcn_sched_barrier(0)
    Unit cur, nxt; int ui = 0;
    if (!S.next(0, cur)) return;
    f32x4 acc[2][2][4][2];
#pragma unroll
    for (int a = 0; a < 2; ++a)
#pragma unroll
        for (int b = 0; b < 2; ++b)
#pragma unroll
            for (int m = 0; m < 4; ++m)
#pragma unroll
                for (int n = 0; n < 2; ++n) acc[a][b][m][n] = (f32x4){0.f, 0.f, 0.f, 0.f};
    bf16x8 At[4][2], B0[2][2], B1[2][2];
    const char* cA = (const char*)g.A + (size_t)cur.pm * tstepA + (size_t)(cur.kinfo & 255) * kstep; const char* cB = (const char*)g.Bt + (size_t)cur.pn * tstepB + (size_t)(cur.kinfo & 255) * kstep;
    S.a_ready(cur);
    if constexpr (SP2) {
        PG8_STAGE(PG8_SB(0, 0), cB, voffB); PG8_STAGE(PG8_SB(0, 1), cB + hstepB, voffB); PG8_STAGE(PG8_SA(0, 0), cA, voffA); PG8_STAGE(PG8_SA(0, 1), cA + hstepA, voffA);
        if (wr == 1) PG8_BAR;
        PG8_WAIT_V(2); PG8_BAR;
        PG8_STAGE(PG8_SB(1, 0), cB + kstep, voffB); PG8_STAGE(PG8_SA(1, 0), cA + kstep, voffA); PG8_STAGE(PG8_SB(1, 1), cB + hstepB + kstep, voffB);
        PG8_WAIT_V(6); PG8_BAR;
    } else {
        PG8_STAGE(PG8_SB(0, 0), cB, voffB); PG8_STAGE(PG8_SA(0, 0), cA, voffA); PG8_STAGE(PG8_SB(0, 1), cB + hstepB, voffB); PG8_STAGE(PG8_SA(0, 1), cA + hstepA, voffA);
        if (wr == 1) PG8_BAR;
        PG8_WAIT_V(4); PG8_BAR;
        PG8_STAGE(PG8_SB(1, 0), cB + kstep, voffB); PG8_STAGE(PG8_SA(1, 0), cA + kstep, voffA); PG8_STAGE(PG8_SB(1, 1), cB + hstepB + kstep, voffB);
        PG8_WAIT_V(6); PG8_BAR;
    }
    for (;;) {
        const bool has_next = S.next(ui + 1, nxt);
        const char* nA = has_next ? (const char*)g.A + (size_t)nxt.pm * tstepA + (size_t)(nxt.kinfo & 255) * kstep : cA; const char* nB = has_next ? (const char*)g.Bt + (size_t)nxt.pn * tstepB + (size_t)(nxt.kinfo & 255) * kstep : cB;
        const int cnt_ = cur.kinfo ? ((cur.kinfo >> 8) & 255) : nt;
        for (int t = 0; t < cnt_; t += 2) {
            const bool last = (t == cnt_ - 2);
            const char* a1 = cA + (size_t)(t + 1) * kstep;
            const char* a2 = last ? nA : cA + (size_t)(t + 2) * kstep; const char* b2 = last ? nB : cB + (size_t)(t + 2) * kstep;
            const char* a3 = a2 + kstep; const char* b3 = b2 + kstep;
            if (last && has_next) S.a_ready(nxt);
            if constexpr (SP2) {
            PG8_LDB(B0, 0, 0); PG8_LDB(B1, 0, 1); PG8_SCHED; PG8_LDA(At, 0, 0); PG8_STAGE(PG8_SA(1, 1), a1 + hstepA, voffA);
            PG8_WAIT_V(8); PG8_WAIT_L(0); PG8_BAR; PG8_MMA(0, 0, At, B0); PG8_MMA(0, 1, At, B1); PG8_BAR; PG8_SCHED;
            PG8_LDA(At, 0, 1); PG8_STAGE(PG8_SB(0, 0), b2, voffB); PG8_STAGE(PG8_SB(0, 1), b2 + hstepB, voffB); PG8_STAGE(PG8_SA(0, 0), a2, voffA);
            PG8_WAIT_V(8); PG8_WAIT_L(0); PG8_BAR; PG8_MMA(1, 0, At, B0); PG8_MMA(1, 1, At, B1); PG8_BAR; PG8_SCHED;
            PG8_LDB(B0, 1, 0); PG8_LDB(B1, 1, 1); PG8_SCHED; PG8_LDA(At, 1, 0); PG8_STAGE(PG8_SA(0, 1), a2 + hstepA, voffA);
            PG8_WAIT_V(8); PG8_WAIT_L(0); PG8_BAR; PG8_MMA(0, 0, At, B0); PG8_MMA(0, 1, At, B1); PG8_BAR; PG8_SCHED;
            PG8_LDA(At, 1, 1); PG8_STAGE(PG8_SB(1, 0), b3, voffB); PG8_STAGE(PG8_SB(1, 1), b3 + hstepB, voffB); PG8_STAGE(PG8_SA(1, 0), a3, voffA);
            PG8_WAIT_V(8); PG8_WAIT_L(0); PG8_BAR; PG8_MMA(1, 0, At, B0); PG8_MMA(1, 1, At, B1); PG8_BAR; PG8_SCHED;
            } else {
            PG8_LDB(B0, 0, 0); PG8_SCHED; PG8_LDA(At, 0, 0); PG8_STAGE(PG8_SA(1, 1), a1 + hstepA, voffA);
            PG8_WAIT_L(8); PG8_BAR; PG8_WAIT_L(0); PG8_MMA(0, 0, At, B0); PG8_BAR; PG8_SCHED;
            PG8_LDB(B1, 0, 1); PG8_STAGE(PG8_SB(0, 0), b2, voffB);
            PG8_BAR; PG8_WAIT_L(0); PG8_MMA(0, 1, At, B1); PG8_BAR;
            PG8_LDA(At, 0, 1); PG8_STAGE(PG8_SA(0, 0), a2, voffA);
            PG8_BAR; PG8_WAIT_L(0); PG8_MMA(1, 0, At, B0); PG8_BAR; PG8_SCHED;
            PG8_STAGE(PG8_SB(0, 1), b2 + hstepB, voffB);
            PG8_WAIT_V(6); PG8_BAR; PG8_MMA(1, 1, At, B1); PG8_BAR;
            PG8_LDB(B0, 1, 0); PG8_SCHED; PG8_LDA(At, 1, 0); PG8_STAGE(PG8_SA(0, 1), a2 + hstepA, voffA);
            PG8_WAIT_L(8); PG8_BAR; PG8_WAIT_L(0); PG8_MMA(0, 0, At, B0); PG8_BAR; PG8_SCHED;
            PG8_LDB(B1, 1, 1); PG8_STAGE(PG8_SB(1, 0), b3, voffB);
            PG8_BAR; PG8_WAIT_L(0); PG8_MMA(0, 1, At, B1); PG8_BAR;
            PG8_LDA(At, 1, 1); PG8_STAGE(PG8_SA(1, 0), a3, voffA);
            PG8_BAR; PG8_WAIT_L(0); PG8_MMA(1, 0, At, B0); PG8_BAR; PG8_SCHED;
            PG8_STAGE(PG8_SB(1, 1), b3 + hstepB, voffB);
            PG8_WAIT_V(6); PG8_BAR; PG8_MMA(1, 1, At, B1); PG8_BAR;
            }
        }
        if constexpr (ALIGN_EPI) { if (wr == 0) PG8_BAR; }
        if constexpr (!Epi::AFTER_DRAIN) { E(acc, cur, wr, wc, fr, fq); S.done(cur); }
        if (!has_next) break;
#pragma unroll
        for (int a = 0; a < 2; ++a)
#pragma unroll
            for (int b = 0; b < 2; ++b)
#pragma unroll
                for (int m = 0; m < 4; ++m)
#pragma unroll
                    for (int n = 0; n < 2; ++n) acc[a][b][m][n] = (f32x4){0.f, 0.f, 0.f, 0.f};
        cur = nxt; cA = nA; cB = nB; ++ui;
        if constexpr (ALIGN_EPI) { if (wr == 1) PG8_BAR; }
    }
    PG8_WAIT_V(0);
    if constexpr (!ALIGN_EPI) { if (wr == 0) PG8_BAR; }
    PG8_BAR;
    if constexpr (Epi::AFTER_DRAIN) { E.fused(acc, cur, wr, wc, fr, fq, lds, wid, lane); S.done(cur); }
#undef PG8_SA
#undef PG8_SB
#undef PG8_STAGE
#undef PG8_LDA
#undef PG8_LDB
#undef PG8_MMA
#undef PG8_WAIT_V
#undef PG8_WAIT_L
#undef PG8_BAR
#undef PG8_SCHED
}
}

#define REP_ATT0 1
#define REP_ATT1 1
#define REP_GU 1
#define REP_NORM 1
#define REP_SYNC 0
#define LAS __attribute__((address_space(3)))
typedef unsigned short bf16_t;
typedef short bf16x8 __attribute__((ext_vector_type(8)));
typedef short s16x4 __attribute__((ext_vector_type(4)));
typedef short v4i16_t __attribute__((ext_vector_type(4)));
typedef float f32x16 __attribute__((ext_vector_type(16)));
typedef float f32x4 __attribute__((ext_vector_type(4)));
typedef unsigned u32x4 __attribute__((ext_vector_type(4)));
typedef unsigned u32x2 __attribute__((ext_vector_type(2)));
using pg8::pk_bf16;

constexpr int D = 1024, NB = 16, SEQ = 2048, CTX = 256, DFF = 2816;
constexpr int ML = NB * SEQ, MC = NB * CTX, MT = ML + MC;
constexpr int P0W = 1280, P1W = 3072;
constexpr int P0P = 1408, P1P = 3200, KVP = 1152, MKP = 896;
constexpr float EPS = 1e-6f, LOG2E = 1.4426950408889634f;
constexpr float LAMBDA_INIT = 0.35550906759096927f;
constexpr size_t MiB = 1u << 20;
constexpr size_t WS_MOD = 0;
constexpr size_t WS_ROPE = 2 * MiB;
constexpr size_t WS_BAR = 3 * MiB;
constexpr size_t WS_HC = 4 * MiB;
constexpr size_t WS_W = 20 * MiB;
constexpr size_t WS_HL = 100 * MiB, WS_HCH = 164 * MiB;
constexpr size_t WS_A = 100 * MiB;
constexpr size_t WS_P = 172 * MiB;
constexpr size_t WS_QF = 271 * MiB, WS_KVF = 325 * MiB;
constexpr size_t WS_MK = 406 * MiB;
constexpr size_t WS_PART = 400 * MiB;
constexpr size_t WS_END = 469 * MiB;
static_assert((size_t)MT * P0P * 2 <= 99 * MiB && (size_t)MT * KVP * 2 <= 81 * MiB && (size_t)MT * MKP * 2 <= 63 * MiB && (size_t)MT * P1P * 2 <= 225 * MiB && (size_t)MT * 768 * 2 <= 54 * MiB, "ws map");
constexpr size_t SZ_GU = (size_t)5632 * 1024, SZ_WD = (size_t)1024 * 2816;
constexpr size_t WO_GU = 0, WO_WD = WO_GU + 4 * SZ_GU, WO_WIN0 = WO_WD + 4 * SZ_WD, WO_WQB = WO_WIN0 + (size_t)1280 * 1024, WO_WKVB = WO_WQB + (size_t)768 * 256,
                 WO_WOUT0 = WO_WKVB + (size_t)1024 * 128, WO_WIN1 = WO_WOUT0 + (size_t)1024 * 1024, WO_WOUT1 = WO_WIN1 + (size_t)3072 * 1024, WO_END = WO_WOUT1 + (size_t)1024 * 1024;
static_assert(WO_END * 2 <= 80 * MiB, "weights fit");
constexpr int LDS_BYTES = 131072 + 1024;

__device__ __forceinline__ float bflo(unsigned u) { return __uint_as_float(u << 16); }
__device__ __forceinline__ float bfhi(unsigned u) { return __uint_as_float(u & 0xffff0000u); }
__device__ __forceinline__ float shx(float v, int mask, int lane) { return __int_as_float(__builtin_amdgcn_ds_bpermute((lane ^ mask) << 2, __float_as_int(v))); }
__device__ __forceinline__ float wave_sum(float v, int lane) {
#pragma unroll
    for (int o = 1; o < 64; o <<= 1) v += shx(v, o, lane);
    return v;
}
#define LDS_WAIT() asm volatile("s_waitcnt lgkmcnt(0)" ::: "memory")

__device__ __forceinline__ void conv_item(const float* __restrict__ W, int K, int N, bf16_t* WT, int mode, LAS float* scr, int item, int lane) {
    const int nblk = N / 32, kb = item / nblk, nb = item % nblk, k0 = 64 * kb, n0 = 32 * nb;
#pragma unroll 8
    for (int i = 0; i < 32; ++i) { const int kk = 2 * i + (lane >> 5); scr[kk * 33 + (lane & 31)] = W[(size_t)(k0 + kk) * N + n0 + (lane & 31)]; }
    LDS_WAIT();
    const int drow0 = mode == 0 ? n0 : mode == 3 ? ((n0 & ~255) + 128 * ((n0 >> 5) & 1) + 32 * ((n0 >> 6) & 3))
                                         : ((n0 >> 7) * 256 + (n0 & 127) + (mode == 2 ? 128 : 0));
    const int c = lane & 7;
#pragma unroll
    for (int j = 0; j < 4; ++j) { const int n = (lane >> 3) + 8 * j; const LAS float* s = scr + (8 * c) * 33 + n;
        u32x4 o; o.x = pk_bf16(s[0 * 33], s[1 * 33]); o.y = pk_bf16(s[2 * 33], s[3 * 33]); o.z = pk_bf16(s[4 * 33], s[5 * 33]); o.w = pk_bf16(s[6 * 33], s[7 * 33]);
        *(u32x4*)(WT + (size_t)(drow0 + n) * K + k0 + 8 * c) = o; }
    LDS_WAIT();
}
__device__ __forceinline__ void sincos_d(double a, float& sn, float& cs) {
    const double k = __builtin_rint(a * 0.63661977236758134308); const double r = a - k * 1.57079632679489661923; const double r2 = r * r;
    const double s = r * (1.0 + r2 * (-1.0 / 6 + r2 * (1.0 / 120 + r2 * (-1.0 / 5040 + r2 * (1.0 / 362880 + r2 * (-1.0 / 39916800))))));
    const double c = 1.0 + r2 * (-0.5 + r2 * (1.0 / 24 + r2 * (-1.0 / 720 + r2 * (1.0 / 40320 + r2 * (-1.0 / 3628800 + r2 * (1.0 / 479001600))))));
    const int q = ((int)k) & 3;
    const double so = (q == 0) ? s : (q == 1) ? c : (q == 2) ? -s : -c;
    const double co = (q == 0) ? c : (q == 1) ? -s : (q == 2) ? -c : s;
    sn = (float)so; cs = (float)co;
}

typedef _Float16 f16x4m __attribute__((ext_vector_type(4)));
__device__ __forceinline__ void norm_phase(const void* lat, bool lat16, const void* ctxp, bool ctx16, int nrows, const float* __restrict__ g, const float* __restrict__ modl, int k, bf16_t* A, int gw, int NGW, int lane, const _Float16* part, _Float16* ctx_out) {
    for (int row = gw; row < nrows; row += NGW) {
        const bool isctx = row >= ML; const size_t ro = (size_t)(isctx ? row - ML : row) * D + 4 * lane; const void* src = isctx ? ctxp : lat; const bool s16 = isctx ? ctx16 : lat16;
        const int bidx = isctx ? 16 : (row >> 11);
        const float* sh = modl + (size_t)bidx * 9216 + (3 * k) * 1024; const float* sc = sh + 1024;
        f32x4 v[4]; float ss = 0.f;
        if (s16) {
#pragma unroll
            for (int j = 0; j < 4; ++j) { const f16x4m hv = *(const f16x4m*)((const _Float16*)src + ro + 256 * j); v[j] = (f32x4){(float)hv[0], (float)hv[1], (float)hv[2], (float)hv[3]}; }
        } else {
#pragma unroll
            for (int j = 0; j < 4; ++j) v[j] = *(const f32x4*)((const float*)src + ro + 256 * j);
        }
        if (isctx && part != nullptr) {
#pragma unroll
            for (int j = 0; j < 4; ++j) { const f16x4m q0 = *(const f16x4m*)(part + ro + 256 * j), q1 = *(const f16x4m*)(part + (size_t)4096 * 1024 + ro + 256 * j), q2 = *(const f16x4m*)(part + (size_t)2 * 4096 * 1024 + ro + 256 * j), q3 = *(const f16x4m*)(part + (size_t)3 * 4096 * 1024 + ro + 256 * j);
                const f32x4 p0 = (f32x4){(float)q0[0], (float)q0[1], (float)q0[2], (float)q0[3]}, p1 = (f32x4){(float)q1[0], (float)q1[1], (float)q1[2], (float)q1[3]}, p2 = (f32x4){(float)q2[0], (float)q2[1], (float)q2[2], (float)q2[3]}, p3 = (f32x4){(float)q3[0], (float)q3[1], (float)q3[2], (float)q3[3]};
                v[j] = v[j] + ((p0 + p1) + (p2 + p3)); f16x4m ho; ho[0] = (_Float16)v[j][0]; ho[1] = (_Float16)v[j][1]; ho[2] = (_Float16)v[j][2]; ho[3] = (_Float16)v[j][3]; *(f16x4m*)(ctx_out + ro + 256 * j) = ho; } }
#pragma unroll
        for (int j = 0; j < 4; ++j) ss += (v[j].x * v[j].x + v[j].y * v[j].y) + (v[j].z * v[j].z + v[j].w * v[j].w);
        ss = wave_sum(ss, lane); const float r = 1.0f / sqrtf(ss * (1.0f / 1024.0f) + EPS);
#pragma unroll
        for (int j = 0; j < 4; ++j) { const int c = 4 * lane + 256 * j; const f32x4 gv = *(const f32x4*)(g + c), scv = *(const f32x4*)(sc + c), shv = *(const f32x4*)(sh + c);
            const f32x4 y = v[j] * r * gv * (scv + 1.0f) + shv;
            u32x2 w; w.x = pk_bf16(y.x, y.y); w.y = pk_bf16(y.z, y.w); *(u32x2*)(A + (size_t)row * D + c) = w; }
    }
}

__device__ __forceinline__ void head_nr64(int lane, bf16_t* hp, const u32x2 w1, const u32x2 w2, int sub, const float* __restrict__ g, bool rope, int t, const float* __restrict__ cs, const float* __restrict__ sn, float oscale, bool dostore) {
    float a[4] = {bflo(w1.x), bfhi(w1.x), bflo(w1.y), bfhi(w1.y)}, b[4] = {bflo(w2.x), bfhi(w2.x), bflo(w2.y), bfhi(w2.y)};
    float ss = 0.f;
#pragma unroll
    for (int e = 0; e < 4; ++e) ss += a[e] * a[e] + b[e] * b[e];
    ss += shx(ss, 1, lane); ss += shx(ss, 2, lane); ss += shx(ss, 4, lane);
    const float r = 1.0f / sqrtf(ss * (1.0f / 64.0f) + EPS);
    const f32x4 g1 = *(const f32x4*)(g + 4 * sub), g2 = *(const f32x4*)(g + 32 + 4 * sub);
#pragma unroll
    for (int e = 0; e < 4; ++e) { a[e] *= r * g1[e]; b[e] *= r * g2[e]; }
    if (rope) { const f32x4 c = *(const f32x4*)(cs + t * 32 + 4 * sub), s = *(const f32x4*)(sn + t * 32 + 4 * sub);
#pragma unroll
        for (int e = 0; e < 4; ++e) { const float na = a[e] * c[e] - b[e] * s[e], nb = a[e] * s[e] + b[e] * c[e]; a[e] = na; b[e] = nb; } }
#pragma unroll
    for (int e = 0; e < 4; ++e) { a[e] *= oscale; b[e] *= oscale; }
    if (dostore) { u32x2 o1, o2; o1.x = pk_bf16(a[0], a[1]); o1.y = pk_bf16(a[2], a[3]); o2.x = pk_bf16(b[0], b[1]); o2.y = pk_bf16(b[2], b[3]);
        *(u32x2*)(hp + 4 * sub) = o1; *(u32x2*)(hp + 32 + 4 * sub) = o2; }
}
__device__ __forceinline__ void head_nr96(int lane, const u32x4 wn, const unsigned wa, const unsigned wb, bf16_t* dst, int sub, const float* __restrict__ g, bool rope, int t, const float* __restrict__ cs, const float* __restrict__ sn, float oscale) {
    float n[8] = {bflo(wn.x), bfhi(wn.x), bflo(wn.y), bfhi(wn.y), bflo(wn.z), bfhi(wn.z), bflo(wn.w), bfhi(wn.w)};
    float a[2] = {bflo(wa), bfhi(wa)}, b[2] = {bflo(wb), bfhi(wb)};
    float ss = a[0] * a[0] + a[1] * a[1] + b[0] * b[0] + b[1] * b[1];
#pragma unroll
    for (int e = 0; e < 8; ++e) ss += n[e] * n[e];
    ss += shx(ss, 1, lane); ss += shx(ss, 2, lane); ss += shx(ss, 4, lane);
    const float r = 1.0f / sqrtf(ss * (1.0f / 96.0f) + EPS);
    const f32x4 ga = *(const f32x4*)(g + 8 * sub), gb = *(const f32x4*)(g + 8 * sub + 4);
#pragma unroll
    for (int e = 0; e < 4; ++e) { n[e] *= r * ga[e] * oscale; n[4 + e] *= r * gb[e] * oscale; }
#pragma unroll
    for (int e = 0; e < 2; ++e) { a[e] *= r * g[64 + 2 * sub + e]; b[e] *= r * g[80 + 2 * sub + e]; }
    if (rope) {
#pragma unroll
        for (int e = 0; e < 2; ++e) { const float c = cs[t * 16 + 2 * sub + e], s = sn[t * 16 + 2 * sub + e]; const float na = a[e] * c - b[e] * s, nb = a[e] * s + b[e] * c; a[e] = na; b[e] = nb; } }
    u32x4 o; o.x = pk_bf16(n[0], n[1]); o.y = pk_bf16(n[2], n[3]); o.z = pk_bf16(n[4], n[5]); o.w = pk_bf16(n[6], n[7]);
    *(u32x4*)(dst + 8 * sub) = o;
    *(unsigned*)(dst + 64 + 2 * sub) = pk_bf16(a[0] * oscale, a[1] * oscale); *(unsigned*)(dst + 80 + 2 * sub) = pk_bf16(b[0] * oscale, b[1] * oscale);
}

#define MFMA32(a, b, c) __builtin_amdgcn_mfma_f32_32x32x16_bf16((a), (b), (c), 0, 0, 0)
__device__ __forceinline__ int crow(int reg, int h) { return (reg & 3) + 8 * (reg >> 2) + 4 * h; }
__device__ __forceinline__ s16x4 vtr(const LAS unsigned char* p) { return __builtin_bit_cast(s16x4, __builtin_amdgcn_ds_read_tr16_b64_v4i16((LAS v4i16_t*)p)); }
__device__ __forceinline__ bf16x8 pack_step(const f32x16& x, int s) {
    u32x4 p; p.x = pk_bf16(x[8 * s + 0], x[8 * s + 1]); p.y = pk_bf16(x[8 * s + 2], x[8 * s + 3]); p.z = pk_bf16(x[8 * s + 4], x[8 * s + 5]); p.w = pk_bf16(x[8 * s + 6], x[8 * s + 7]);
    return __builtin_bit_cast(bf16x8, p);
}
template <int DQK, int DV, int KW, bool MASK>
__device__ __forceinline__ void attn_run(LAS unsigned char* lds, int tid, const bf16_t* __restrict__ Kg, int kpitch, const bf16_t* __restrict__ Vg, int vpitch,
                                         int ctx_row0, int lat_row0, int nt, const bf16x8 (&qf)[DQK / 16], int koffB, int qpos, int kpos0, bool late,
                                         f32x16 (&o)[DV / 32], float& m_out, float& l_out) {
    constexpr int KP = KW * 2 + 16, VP = DV * 2 + 64, KB = 64 * KP, VB = 64 * VP;
    constexpr int KCPR = KW / 8, VCPR = DV / 8, NKC = 64 * KCPR, NVC = 64 * VCPR, NKI = (NKC + 511) / 512, NVI = (NVC + 511) / 512;
    static_assert(2 * KB + 3 * VB <= 131072, "attention tiles fit");
    static_assert(NVC % 512 == 0, "V chunks");
    const int lane = tid & 63, r = lane & 31, h = lane >> 5;
    const int q4 = (lane & 15) >> 2, p4 = lane & 3, blk = (lane >> 4) & 1;
    unsigned vlane = (unsigned)((4 * h + q4) * VP + 32 * blk + 8 * p4), klane = (unsigned)(r * KP + koffB + h * 16); asm volatile("" : "+v"(vlane), "+v"(klane));
    unsigned kst[NKI], vst[NVI];
#pragma unroll
    for (int i_ = 0; i_ < NKI; ++i_) { const int c_ = tid + 512 * i_; kst[i_] = (unsigned)((c_ / KCPR) * KP + (c_ % KCPR) * 16); asm volatile("" : "+v"(kst[i_])); }
#pragma unroll
    for (int i_ = 0; i_ < NVI; ++i_) { const int c_ = tid + 512 * i_; vst[i_] = (unsigned)((c_ / VCPR) * VP + (c_ % VCPR) * 16); asm volatile("" : "+v"(vst[i_])); }
    u32x4 kregA[NKI], vregA[NVI];
#define ATT_GLOAD(t, KR, VR) do { const int tr_ = (t) < 4 ? ctx_row0 + 64 * (t) : lat_row0 + 64 * ((t) - 4); \
        _Pragma("unroll") for (int i_ = 0; i_ < NKI; ++i_) { const int c_ = tid + 512 * i_; if ((NKC % 512 == 0) || c_ < NKC) { const int rr_ = c_ / KCPR, cc_ = c_ % KCPR; KR[i_] = *(const u32x4*)(Kg + (size_t)(tr_ + rr_) * kpitch + cc_ * 8); } } \
        _Pragma("unroll") for (int i_ = 0; i_ < NVI; ++i_) { const int c_ = tid + 512 * i_; const int rr_ = c_ / VCPR, cc_ = c_ % VCPR; VR[i_] = *(const u32x4*)(Vg + (size_t)(tr_ + rr_) * vpitch + cc_ * 8); } } while (0)
#define ATT_LSTORE(kslot, vslot, KR, VR) do { LAS unsigned char* kb_ = lds + (kslot) * KB; LAS unsigned char* vb_ = lds + 2 * KB + (vslot) * VB; \
        _Pragma("unroll") for (int i_ = 0; i_ < NKI; ++i_) { const int c_ = tid + 512 * i_; if ((NKC % 512 == 0) || c_ < NKC) { *(LAS u32x4*)(kb_ + kst[i_]) = KR[i_]; } } \
        _Pragma("unroll") for (int i_ = 0; i_ < NVI; ++i_) { *(LAS u32x4*)(vb_ + vst[i_]) = VR[i_]; } } while (0)
#define ATT_SB() __builtin_amdgcn_sched_barrier(0)
#define ATT_BAR() do { asm volatile("s_waitcnt lgkmcnt(0)" ::: "memory"); __builtin_amdgcn_s_barrier(); asm volatile("" ::: "memory"); } while (0)
#define ATT_VLOAD(dst, vb_, c_) do { _Pragma("unroll") for (int e_ = 0; e_ < 2; ++e_) { const int g_ = (c_) / (DV / 64), db_ = 2 * ((c_) % (DV / 64)) + e_; \
            const LAS unsigned char* vp_ = (vb_) + ((32 * (g_ >> 1) + 16 * (g_ & 1)) * VP + 64 * db_); \
            const s16x4 lo_ = vtr(vp_), hi_ = vtr(vp_ + 8 * VP); dst[e_] = __builtin_shufflevector(lo_, hi_, 0, 1, 2, 3, 4, 5, 6, 7); } } while (0)
#define ATT_PVM(src, c_) do { _Pragma("unroll") for (int e_ = 0; e_ < 2; ++e_) { const int g_ = (c_) / (DV / 64), db_ = 2 * ((c_) % (DV / 64)) + e_; o[db_] = MFMA32(src[e_], pw[g_], o[db_]); } } while (0)
#define ATT_PV(vbase) do { const LAS unsigned char* vbp_ = (vbase); bf16x8 va_[2], vc_[2]; constexpr int NC_ = 4 * (DV / 64); \
        ATT_VLOAD(va_, vbp_, 0); ATT_SB(); \
        _Pragma("unroll") for (int c2_ = 0; c2_ < NC_; c2_ += 2) { \
            ATT_VLOAD(vc_, vbp_, c2_ + 1); ATT_SB(); ATT_PVM(va_, c2_); ATT_SB(); \
            if (c2_ + 2 < NC_) { ATT_VLOAD(va_, vbp_, c2_ + 2); } ATT_SB(); ATT_PVM(vc_, c2_ + 1); ATT_SB(); } } while (0)
    ATT_GLOAD(0, kregA, vregA); ATT_LSTORE(0, 0, kregA, vregA);
    ATT_BAR();
    float m = 0.f, l = 0.f; f32x16 negm; { float z_ = 0.f; asm volatile("" : "+v"(z_));
#pragma unroll
    for (int i = 0; i < 16; ++i) negm[i] = z_; }
    bf16x8 pw[4];
#pragma unroll
    for (int i = 0; i < 4; ++i) pw[i] = (bf16x8){0, 0, 0, 0, 0, 0, 0, 0};
    int vcur = 0, vprev = 0;
    for (int t2 = 0; t2 < nt; t2 += 2) {
#pragma unroll
    for (int par = 0; par < 2; ++par) { const int t = t2 + par; if (t < nt) {
        const int vnext = (vcur == 2) ? 0 : vcur + 1;
        if (t + 1 < nt) ATT_GLOAD(t + 1, kregA, vregA);
        const LAS unsigned char* kb = lds + (t & 1) * KB + klane;
        bf16x8 kf[2 * (DQK / 16)];
#pragma unroll
        for (int d0 = 0; d0 < DQK / 16; ++d0) {
            kf[2 * d0] = *(const LAS bf16x8*)(kb + d0 * 32);
            kf[2 * d0 + 1] = *(const LAS bf16x8*)(kb + 32 * KP + d0 * 32);
        }
        ATT_SB();
        if (late && t > 0) ATT_PV(lds + 2 * KB + vprev * VB + vlane);
        f32x16 s0 = negm, s1 = negm;
#pragma unroll
        for (int d0 = 0; d0 < DQK / 16; ++d0) { s0 = MFMA32(kf[2 * d0], qf[d0], s0); s1 = MFMA32(kf[2 * d0 + 1], qf[d0], s1); }
        ATT_SB();
        if (MASK) { if (t >= 4) { const int dq = kpos0 + 64 * (t - 4) - qpos;
#pragma unroll
            for (int i = 0; i < 16; ++i) { const int d0_ = dq + crow(i, h); if (d0_ > 128 || d0_ < -128) s0[i] = -INFINITY; const int d1_ = d0_ + 32; if (d1_ > 128 || d1_ < -128) s1[i] = -INFINITY; } } }
        float mt = __builtin_fmaxf(s0[0], s1[0]), mu = __builtin_fmaxf(s0[1], s1[1]);
#pragma unroll
        for (int i = 2; i < 16; i += 2) { mt = __builtin_fmaxf(__builtin_fmaxf(mt, s0[i]), s1[i]); mu = __builtin_fmaxf(__builtin_fmaxf(mu, s0[i + 1]), s1[i + 1]); }
        mt = __builtin_fmaxf(mt, mu);
        { auto rr = __builtin_amdgcn_permlane32_swap(__float_as_uint(mt), __float_as_uint(mt), false, false); mt = fmaxf(__uint_as_float(rr[0]), __uint_as_float(rr[1])); }
        constexpr float THR = 8.0f;
        if (t == 0 || __builtin_amdgcn_ballot_w64(mt > THR) != 0ull) {
            const float delta = (t == 0) ? mt : __builtin_fmaxf(mt, 0.f);
            if (t != 0) { const float alpha = __builtin_amdgcn_exp2f(-delta); l *= alpha;
#pragma unroll
                for (int db = 0; db < DV / 32; ++db)
#pragma unroll
                    for (int i = 0; i < 16; ++i) o[db][i] *= alpha; }
            m += delta;
#pragma unroll
            for (int i = 0; i < 16; ++i) { s0[i] -= delta; s1[i] -= delta; negm[i] = -m; }
            asm volatile("" : "+v"(negm));
        }
        float ps = 0.f;
#pragma unroll
        for (int i = 0; i < 16; ++i) { s0[i] = __builtin_amdgcn_exp2f(s0[i]); s1[i] = __builtin_amdgcn_exp2f(s1[i]); ps += s0[i] + s1[i]; }
        l += ps;
        pw[0] = pack_step(s0, 0); pw[1] = pack_step(s0, 1); pw[2] = pack_step(s1, 0); pw[3] = pack_step(s1, 1);
        if (!late) ATT_PV(lds + 2 * KB + vcur * VB + vlane);
        if (t + 1 < nt) ATT_LSTORE((t + 1) & 1, vnext, kregA, vregA);
        vprev = vcur; vcur = vnext;
        ATT_BAR();
    } } }
    if (late) ATT_PV(lds + 2 * KB + vprev * VB + vlane);
    ATT_BAR();
    m_out = m; l_out = l;
#undef ATT_GLOAD
#undef ATT_LSTORE
#undef ATT_PV
#undef ATT_PVM
#undef ATT_VLOAD
#undef ATT_SB
#undef ATT_BAR
}

template <int DQK, int DV, int KW, bool MASK>
__device__ __forceinline__ void attn_run2(LAS unsigned char* lds, int tid, const bf16_t* __restrict__ Kg, int kpitch, const bf16_t* __restrict__ Vg, int vpitch,
                                          int ctx_row0, int lat_row0, int nt, const bf16x8 (&qf)[DQK / 16], int koffB, int qpos, int kpos0,
                                          f32x16 (&o)[DV / 32], float& m_out, float& l_out) {
    constexpr int KP = KW * 2 + 16, VP = DV * 2 + 64, KB = 64 * KP, VB = 64 * VP, ND = DQK / 16;
    constexpr int KCPR = KW / 8, VCPR = DV / 8, NKC = 64 * KCPR, NVC = 64 * VCPR, NKI = (NKC + 511) / 512, NVI = (NVC + 511) / 512;
    static_assert(2 * KB + 3 * VB <= 131072 && NVC % 512 == 0 && ND % 2 == 0, "attention tiles");
    const int lane = tid & 63, r = lane & 31, h = lane >> 5;
    const int q4 = (lane & 15) >> 2, p4 = lane & 3, blk = (lane >> 4) & 1;
    u32x4 kregA[NKI], vregA[NVI], kregB[NKI], vregB[NVI];
#define A2_GLOAD(t, KR, VR) do { const int tr_ = (t) < 4 ? ctx_row0 + 64 * (t) : lat_row0 + 64 * ((t) - 4); \
        _Pragma("unroll") for (int i_ = 0; i_ < NKI; ++i_) { const int c_ = tid + 512 * i_; if ((NKC % 512 == 0) || c_ < NKC) { const int rr_ = c_ / KCPR, cc_ = c_ % KCPR; KR[i_] = *(const u32x4*)(Kg + (size_t)(tr_ + rr_) * kpitch + cc_ * 8); } } \
        _Pragma("unroll") for (int i_ = 0; i_ < NVI; ++i_) { const int c_ = tid + 512 * i_; const int rr_ = c_ / VCPR, cc_ = c_ % VCPR; VR[i_] = *(const u32x4*)(Vg + (size_t)(tr_ + rr_) * vpitch + cc_ * 8); } } while (0)
#define A2_LSTORE(kslot, vslot, KR, VR) do { LAS unsigned char* kb_ = lds + (kslot) * KB; LAS unsigned char* vb_ = lds + 2 * KB + (vslot) * VB; \
        _Pragma("unroll") for (int i_ = 0; i_ < NKI; ++i_) { const int c_ = tid + 512 * i_; if ((NKC % 512 == 0) || c_ < NKC) { const int rr_ = c_ / KCPR, cc_ = c_ % KCPR; *(LAS u32x4*)(kb_ + rr_ * KP + cc_ * 16) = KR[i_]; } } \
        _Pragma("unroll") for (int i_ = 0; i_ < NVI; ++i_) { const int c_ = tid + 512 * i_; const int rr_ = c_ / VCPR, cc_ = c_ % VCPR; *(LAS u32x4*)(vb_ + rr_ * VP + cc_ * 16) = VR[i_]; } } while (0)
#define A2_SB() __builtin_amdgcn_sched_barrier(0)
#define A2_KFRAG(kb_, d0_, half_) (*(const LAS bf16x8*)((kb_) + ((half_) * 32 + r) * KP + koffB + (d0_) * 32 + h * 16))
#define A2_EL(P0, P1, e_) (((e_) < 16) ? P0[(e_) & 15] : P1[(e_) & 15])
#define A2_FILLA(P0, P1, j_) do { if ((j_) < 8) { const int e_ = 4 * (j_); \
        sacc += (A2_EL(P0, P1, e_) + A2_EL(P0, P1, e_ + 1)) + (A2_EL(P0, P1, e_ + 2) + A2_EL(P0, P1, e_ + 3)); \
        pw[((j_) >> 2) * 2 + (((j_) & 3) >> 1)][2 * ((j_) & 1)] = pk_bf16(A2_EL(P0, P1, e_), A2_EL(P0, P1, e_ + 1)); \
        pw[((j_) >> 2) * 2 + (((j_) & 3) >> 1)][2 * ((j_) & 1) + 1] = pk_bf16(A2_EL(P0, P1, e_ + 2), A2_EL(P0, P1, e_ + 3)); } } while (0)
#define A2_QK(S0, S1, kb_, FILL, P0, P1) do { bf16x8 ka_[2], kc_[2]; \
        ka_[0] = A2_KFRAG(kb_, 0, 0); ka_[1] = A2_KFRAG(kb_, 0, 1); A2_SB(); \
        _Pragma("unroll") for (int d_ = 0; d_ < ND; d_ += 2) { \
            kc_[0] = A2_KFRAG(kb_, d_ + 1, 0); kc_[1] = A2_KFRAG(kb_, d_ + 1, 1); A2_SB(); \
            S0 = MFMA32(ka_[0], qf[d_], S0); if (FILL) A2_FILLA(P0, P1, 2 * d_); A2_SB(); \
            S1 = MFMA32(ka_[1], qf[d_], S1); if (FILL) A2_FILLA(P0, P1, 2 * d_ + 1); A2_SB(); \
            if (d_ + 2 < ND) { ka_[0] = A2_KFRAG(kb_, d_ + 2, 0); ka_[1] = A2_KFRAG(kb_, d_ + 2, 1); } A2_SB(); \
            S0 = MFMA32(kc_[0], qf[d_ + 1], S0); if (FILL) A2_FILLA(P0, P1, 2 * d_ + 2); A2_SB(); \
            S1 = MFMA32(kc_[1], qf[d_ + 1], S1); if (FILL) A2_FILLA(P0, P1, 2 * d_ + 3); A2_SB(); } } while (0)
#define A2_VLOAD(dst, vb_, c_) do { _Pragma("unroll") for (int e_ = 0; e_ < 2; ++e_) { const int g_ = (c_) / (DV / 64), db_ = 2 * ((c_) % (DV / 64)) + e_; \
            const LAS unsigned char* vp_ = (vb_) + (32 * (g_ >> 1) + 16 * (g_ & 1) + 4 * h + q4) * VP + (32 * db_ + 16 * blk) * 2 + 8 * p4; \
            const s16x4 lo_ = vtr(vp_), hi_ = vtr(vp_ + 8 * VP); dst[e_] = __builtin_shufflevector(lo_, hi_, 0, 1, 2, 3, 4, 5, 6, 7); } } while (0)
#define A2_FILLB(S0, S1, gap_) do { constexpr int EPG_ = 32 / (8 * (DV / 64)); _Pragma("unroll") for (int i_ = 0; i_ < EPG_; ++i_) { const int e_ = (gap_) * EPG_ + i_; \
        if (e_ < 16) S0[e_ & 15] = __builtin_amdgcn_exp2f(S0[e_ & 15] - m); else S1[e_ & 15] = __builtin_amdgcn_exp2f(S1[e_ & 15] - m); } } while (0)
#define A2_PVM1(src, c_, e_) do { const int g_ = (c_) / (DV / 64), db_ = 2 * ((c_) % (DV / 64)) + (e_); o[db_] = MFMA32(src[e_], __builtin_bit_cast(bf16x8, pw[g_]), o[db_]); } while (0)
#define A2_PV(vbase, S0, S1, DOEXP) do { const LAS unsigned char* vbp_ = (vbase); bf16x8 va_[2], vc_[2]; constexpr int NC_ = 4 * (DV / 64); \
        A2_VLOAD(va_, vbp_, 0); A2_SB(); \
        _Pragma("unroll") for (int c2_ = 0; c2_ < NC_; c2_ += 2) { \
            A2_VLOAD(vc_, vbp_, c2_ + 1); A2_SB(); \
            A2_PVM1(va_, c2_, 0); if (DOEXP) A2_FILLB(S0, S1, 2 * c2_); A2_SB(); \
            A2_PVM1(va_, c2_, 1); if (DOEXP) A2_FILLB(S0, S1, 2 * c2_ + 1); A2_SB(); \
            if (c2_ + 2 < NC_) { A2_VLOAD(va_, vbp_, c2_ + 2); } A2_SB(); \
            A2_PVM1(vc_, c2_ + 1, 0); if (DOEXP) A2_FILLB(S0, S1, 2 * c2_ + 2); A2_SB(); \
            A2_PVM1(vc_, c2_ + 1, 1); if (DOEXP) A2_FILLB(S0, S1, 2 * c2_ + 3); A2_SB(); } } while (0)
#define A2_ZERO(S0, S1) do { _Pragma("unroll") for (int i_ = 0; i_ < 16; ++i_) { S0[i_] = 0.f; S1[i_] = 0.f; } } while (0)
#define A2_MASK(S0, S1, t_) do { if (MASK) { if ((t_) >= 4) { const int dq_ = kpos0 + 64 * ((t_) - 4) - qpos; \
        _Pragma("unroll") for (int i_ = 0; i_ < 16; ++i_) { const int d0_ = dq_ + crow(i_, h); if (d0_ > 128 || d0_ < -128) S0[i_] = -INFINITY; const int d1_ = d0_ + 32; if (d1_ > 128 || d1_ < -128) S1[i_] = -INFINITY; } } } } while (0)
#define A2_ROWMAX(S0, S1, mt_) do { mt_ = fmaxf(S0[0], S1[0]); _Pragma("unroll") for (int i_ = 1; i_ < 16; ++i_) mt_ = fmaxf(mt_, fmaxf(S0[i_], S1[i_])); \
        auto rr_ = __builtin_amdgcn_permlane32_swap(__float_as_uint(mt_), __float_as_uint(mt_), false, false); mt_ = fmaxf(__uint_as_float(rr_[0]), __uint_as_float(rr_[1])); } while (0)
#define A2_BAR() do { asm volatile("s_waitcnt lgkmcnt(0)" ::: "memory"); __builtin_amdgcn_s_barrier(); asm volatile("" ::: "memory"); } while (0)
#define A2_STEP(t_, S0, S1, P0, P1, KRL, VRL, KRS, VRS) do { \
        const int vnext_ = (vcur == 2) ? 0 : vcur + 1; \
        if ((t_) + 2 < nt) A2_GLOAD((t_) + 2, KRL, VRL); \
        const LAS unsigned char* kbs_ = lds + ((t_) & 1) * KB; \
        float sacc = 0.f; A2_ZERO(S0, S1); \
        A2_QK(S0, S1, kbs_, true, P0, P1); \
        l += sacc; \
        A2_MASK(S0, S1, t_); \
        float mt_; A2_ROWMAX(S0, S1, mt_); \
        const float mn_ = fmaxf(m, mt_); const bool resc_ = __builtin_amdgcn_ballot_w64(mn_ > m) != 0ull; float alpha_ = 1.0f; \
        if (resc_) { alpha_ = __builtin_amdgcn_exp2f(m - mn_); l *= alpha_; m = mn_; } \
        A2_PV(lds + 2 * KB + vprev * VB, S0, S1, true); \
        if (resc_) { _Pragma("unroll") for (int db_ = 0; db_ < DV / 32; ++db_) _Pragma("unroll") for (int i_ = 0; i_ < 16; ++i_) o[db_][i_] *= alpha_; } \
        if ((t_) + 1 < nt) A2_LSTORE(((t_) + 1) & 1, vnext_, KRS, VRS); \
        vprev = vcur; vcur = vnext_; \
        A2_BAR(); } while (0)
    f32x16 sA0, sA1, sB0, sB1; u32x4 pw[4]; float m, l = 0.f;
    int vcur = 0, vprev = 0;
    A2_GLOAD(0, kregA, vregA); A2_LSTORE(0, 0, kregA, vregA);
    if (1 < nt) A2_GLOAD(1, kregB, vregB);
    A2_BAR();
    {
        if (2 < nt) A2_GLOAD(2, kregA, vregA);
        A2_ZERO(sA0, sA1); float sacc = 0.f;
        A2_QK(sA0, sA1, lds, false, sA0, sA1); (void)sacc;
        A2_MASK(sA0, sA1, 0);
        float mt_; A2_ROWMAX(sA0, sA1, mt_); m = mt_;
#pragma unroll
        for (int i = 0; i < 16; ++i) { sA0[i] = __builtin_amdgcn_exp2f(sA0[i] - m); sA1[i] = __builtin_amdgcn_exp2f(sA1[i] - m); }
        if (1 < nt) A2_LSTORE(1, 1, kregB, vregB);
        vprev = 0; vcur = 1;
        A2_BAR();
    }
    for (int t2 = 1; t2 < nt; t2 += 2) {
        A2_STEP(t2, sB0, sB1, sA0, sA1, kregB, vregB, kregA, vregA);
        if (t2 + 1 < nt) A2_STEP(t2 + 1, sA0, sA1, sB0, sB1, kregA, vregA, kregB, vregB);
    }
    {
        float sacc = 0.f;
        if ((nt - 1) & 1) {
#pragma unroll
            for (int j = 0; j < 8; ++j) A2_FILLA(sB0, sB1, j);
        } else {
#pragma unroll
            for (int j = 0; j < 8; ++j) A2_FILLA(sA0, sA1, j);
        }
        l += sacc;
        A2_PV(lds + 2 * KB + vprev * VB, sA0, sA1, false);
    }
    __syncthreads();
    m_out = m; l_out = l;
#undef A2_GLOAD
#undef A2_LSTORE
#undef A2_SB
#undef A2_KFRAG
#undef A2_EL
#undef A2_FILLA
#undef A2_QK
#undef A2_VLOAD
#undef A2_FILLB
#undef A2_PVM1
#undef A2_PV
#undef A2_ZERO
#undef A2_MASK
#undef A2_ROWMAX
#undef A2_STEP
#undef A2_BAR
}
template <int NDB>
__device__ __forceinline__ void write_o(int lane, const f32x16 (&o)[NDB], float l, float m, bool sink, float sinkv, bf16_t* obase, int hh, LAS unsigned char* stg) {
    float lt = l + shx(l, 32, lane); if (sink) lt += __builtin_amdgcn_exp2f(sinkv - m);
    const float inv = 1.0f / lt;
    constexpr int RB = NDB * 64 + 16, CPR = NDB * 4;
    LAS unsigned char* wp = stg + (lane & 31) * RB + 8 * hh;
#pragma unroll
    for (int db = 0; db < NDB; ++db)
#pragma unroll
        for (int g = 0; g < 4; ++g) { u32x2 w; w.x = pk_bf16(o[db][4 * g] * inv, o[db][4 * g + 1] * inv); w.y = pk_bf16(o[db][4 * g + 2] * inv, o[db][4 * g + 3] * inv);
            *(LAS u32x2*)(wp + 64 * db + 16 * g) = w; }
    asm volatile("s_waitcnt lgkmcnt(0)" ::: "memory");
#pragma unroll
    for (int i = 0; i < 32 * CPR / 64; ++i) { const int c = i * 64 + lane, row = c / CPR, ch = c % CPR;
        const u32x4 v = *(const LAS u32x4*)(stg + row * RB + ch * 16); *(u32x4*)(obase + (size_t)row * 1024 + ch * 8) = v; }
    asm volatile("s_waitcnt lgkmcnt(0)" ::: "memory");
}

#define XB_TMO      128
#define XB_XCNT(j)  (256  + 64 * (j))
#define XB_XSUB(j)  (1280 + 64 * (j))
#define XB_XGEN(j)  (2304 + 64 * (j))
#define XB_TOP      3328
#define XB_TOPGEN   3392
#define XCD_BAR_WORDS 3456
#define XB_SPIN_CAP (1u << 18)
__device__ __forceinline__ unsigned xb_ld(unsigned* p)              { return __hip_atomic_load(p, __ATOMIC_RELAXED, __HIP_MEMORY_SCOPE_AGENT); }
__device__ __forceinline__ unsigned xb_add(unsigned* p, unsigned v) { return __hip_atomic_fetch_add(p, v, __ATOMIC_RELAXED, __HIP_MEMORY_SCOPE_AGENT); }
__device__ __forceinline__ unsigned xb_xcc_id() { return (unsigned)__builtin_amdgcn_s_getreg((3 << 11) | 20) & 0xFu; }
#define XB_SPIN(cond, bar) do { unsigned _sp = 0; while (cond) { __builtin_amdgcn_s_sleep(1); \
    if ((++_sp & 255u) == 0u) { if (xb_ld(&(bar)[XB_TMO])) break; if (_sp > XB_SPIN_CAP) { atomicAdd(&(bar)[XB_TMO], 1u); break; } } } } while (0)
__device__ __forceinline__ void xcd_barrier_complete(unsigned* bar, unsigned x, unsigned& nloc, unsigned& nx) {
    const unsigned G = gridDim.x * gridDim.y * gridDim.z;
    unsigned sum, cnt, mine, sp = 0u;
    for (;;) {
        sum = 0u; cnt = 0u; mine = 0u;
#pragma unroll
        for (unsigned j = 0; j < 16; ++j) { const unsigned c = xb_ld(&bar[XB_XCNT(j)]); sum += c; cnt += (c > 0u) ? 1u : 0u; mine = (j == x) ? c : mine; }
        if (sum == G) break;
        __builtin_amdgcn_s_sleep(1);
        if ((++sp & 255u) == 0u) { if (xb_ld(&bar[XB_TMO])) break; if (sp > XB_SPIN_CAP) { atomicAdd(&bar[XB_TMO], 1u); break; } }
    }
    nloc = mine > 0u ? mine : 1u; nx = cnt > 0u ? cnt : 1u;
}
__device__ __forceinline__ void xcd_barrier(unsigned* bar, volatile LAS unsigned* st, int tid) {
    asm volatile("s_waitcnt vmcnt(0)" ::: "memory");
    __syncthreads();
    if (tid == 0) {
        const unsigned x = xb_xcc_id();
        __builtin_amdgcn_s_waitcnt(0);
        unsigned nloc = st[0], nx = st[1];
        if (nloc == 0u) { xcd_barrier_complete(bar, x, nloc, nx); st[0] = nloc; st[1] = nx; }
        const unsigned old = xb_add(&bar[XB_XSUB(x)], 1u);
        const unsigned gen = old / nloc;
        if (old + 1u == (gen + 1u) * nloc) {
            __builtin_amdgcn_fence(__ATOMIC_RELEASE, "agent");
            asm volatile("s_waitcnt vmcnt(0)" ::: "memory");
            const unsigned og = xb_add(&bar[XB_TOP], 1u);
            const unsigned tg = og / nx;
            if (og + 1u == (tg + 1u) * nx) xb_add(&bar[XB_TOPGEN], 1u);
            else XB_SPIN(xb_ld(&bar[XB_TOPGEN]) == tg, bar);
            __builtin_amdgcn_fence(__ATOMIC_ACQUIRE, "agent");
            xb_add(&bar[XB_XGEN(x)], 1u);
            asm volatile("s_waitcnt vmcnt(0)" ::: "memory");
        } else {
            XB_SPIN(xb_ld(&bar[XB_XGEN(x)]) == gen, bar);
            __builtin_amdgcn_fence(__ATOMIC_ACQUIRE, "agent");
            asm volatile("s_waitcnt vmcnt(0)" ::: "memory");
        }
    }
    __syncthreads();
}

struct Args { const float* in[36]; float* out; unsigned char* ws; };

__global__ void __launch_bounds__(512) fwd_megakernel(Args a) {
    extern __shared__ __attribute__((aligned(16))) unsigned char lds_raw[];
    LAS unsigned char* lds = (LAS unsigned char*)lds_raw;
    const int wave0 = __builtin_amdgcn_readfirstlane((int)threadIdx.x >> 6);
    typedef const __attribute__((address_space(4))) unsigned char* kptr_t;
    const int G = gridDim.x, bid = blockIdx.x, NGW = G * 8;
#define PHASE_IDS() int tid; asm volatile("v_mbcnt_lo_u32_b32 %0, -1, 0\n\tv_mbcnt_hi_u32_b32 %0, -1, %0" : "=v"(tid)); tid += wave0 * 64; const int lane = tid & 63; const int wave = __builtin_amdgcn_readfirstlane(tid >> 6); const int gw = bid * 8 + wave; (void)lane; (void)wave; (void)gw; \
    kptr_t ka_ = (kptr_t)__builtin_amdgcn_kernarg_segment_ptr(); asm volatile("" : "+s"(ka_)); \
    unsigned char* ws = *(unsigned char* const __attribute__((address_space(4)))*)(ka_ + 37 * 8); float* OUT = *(float* const __attribute__((address_space(4)))*)(ka_ + 36 * 8); \
    float* modtab = (float*)(ws + WS_MOD); float* cos64 = (float*)(ws + WS_ROPE); float* sin64 = cos64 + 2048 * 32; float* cos32 = sin64 + 2048 * 32; float* sin32 = cos32 + 2048 * 16; \
    float* HC = (float*)(ws + WS_HC); bf16_t* W = (bf16_t*)(ws + WS_W); bf16_t* A = (bf16_t*)OUT; _Float16* HL = (_Float16*)(ws + WS_HL); _Float16* HCh = (_Float16*)(ws + WS_HCH); (void)HL; (void)HCh; bf16_t* U = (bf16_t*)(ws + WS_P); bf16_t* P1 = U; bf16_t* P0 = U; \
    bf16_t* Qf = (bf16_t*)(ws + WS_QF); bf16_t* KVf = (bf16_t*)(ws + WS_KVF); bf16_t* MK = (bf16_t*)(ws + WS_MK); \
    const float* modl = modtab + (size_t)l * 17 * 9216; const float* ng = l ? IN(23) : IN(6); \
    (void)modtab; (void)cos64; (void)sin64; (void)cos32; (void)sin32; (void)HC; (void)W; (void)A; (void)U; (void)P1; (void)P0; (void)Qf; (void)KVf; (void)MK; (void)OUT; (void)modl; (void)ng
#define IN(i) (*(const float* const __attribute__((address_space(4)))*)(ka_ + 8 * (i)))
#define PHASE_IDS0() const int l = 0; PHASE_IDS()
#define GRID_BAR() do { int tb_; asm volatile("v_mbcnt_lo_u32_b32 %0, -1, 0\n\tv_mbcnt_hi_u32_b32 %0, -1, %0" : "=v"(tb_)); tb_ += wave0 * 64; \
    kptr_t kb_ = (kptr_t)__builtin_amdgcn_kernarg_segment_ptr(); asm volatile("" : "+s"(kb_)); unsigned char* wsb_ = *(unsigned char* const __attribute__((address_space(4)))*)(kb_ + 37 * 8); \
    xcd_barrier((unsigned*)(wsb_ + WS_BAR), (volatile LAS unsigned*)(lds + 131072 + 512), tb_); } while (0)

    {
        const int l = 0; PHASE_IDS();
        if (tid < 2) ((volatile LAS unsigned*)(lds + 131072 + 512))[tid] = 0u;
        if (bid == 0) { unsigned* bar = (unsigned*)(ws + WS_BAR); for (int i = tid; i < XCD_BAR_WORDS; i += 512) __hip_atomic_store(&bar[i], 0u, __ATOMIC_RELAXED, __HIP_MEMORY_SCOPE_AGENT); }
        for (int i = bid * 512 + tid; i < 2048 * 32 + 2048 * 16; i += G * 512) {
            if (i < 2048 * 32) { const int t = i >> 5, f = i & 31; const float inv = exp2f(-(float)(f & 15) * (13.287712379549449f / 16.0f)); const float pos = (f < 16) ? (float)(t >> 6) : (float)(t & 63);
                const float ang = pos * inv; float sn, cs; sincos_d((double)ang, sn, cs); cos64[i] = cs; sin64[i] = sn; }
            else { const int j = i - 2048 * 32; const int t = j >> 4, f = j & 15; const float inv = exp2f(-(float)(f & 7) * (13.287712379549449f / 8.0f)); const float pos = (f < 8) ? (float)(t >> 6) : (float)(t & 63);
                const float ang = pos * inv; float sn, cs; sincos_d((double)ang, sn, cs); cos32[j] = cs; sin32[j] = sn; }
        }
        for (int i = bid * 512 + tid; i < 96 * 1024 / 8; i += G * 512) *(u32x4*)(W + WO_WIN0 + (size_t)1184 * 1024 + (size_t)i * 8) = (u32x4){0u, 0u, 0u, 0u};
        if (bid < 288) {
            LAS float* sc = (LAS float*)lds;
            LAS float* part = sc + 17 * 1024;
            for (int i = tid; i < 17 * 1024; i += 512) { const float v = i < 16 * 1024 ? IN(1)[i] : IN(3)[i - 16 * 1024]; sc[i] = v / (1.0f + expf(-v)); }
            __syncthreads();
            for (int task = bid; task < 288; task += G) {
                const int l = task / 144, gq = task % 144, j = gq * 64 + lane;
                const float* aw = l ? IN(21) : IN(4); const float* ab = l ? IN(22) : IN(5);
                float acc[17];
#pragma unroll
                for (int b = 0; b < 17; ++b) acc[b] = 0.f;
                const int kbeg = wave * 128;
#pragma unroll 4
                for (int k = kbeg; k < kbeg + 128; ++k) { const float w = aw[(size_t)k * 9216 + j];
#pragma unroll
                    for (int b = 0; b < 17; ++b) acc[b] += sc[b * 1024 + k] * w; }
#pragma unroll
                for (int b = 0; b < 17; ++b) part[(wave * 17 + b) * 64 + lane] = acc[b];
                __syncthreads();
                for (int o = tid; o < 17 * 64; o += 512) { const int b = o >> 6, ln = o & 63; float s = 0.f;
#pragma unroll
                    for (int w = 0; w < 8; ++w) s += part[(w * 17 + b) * 64 + ln];
                    modtab[(size_t)(l * 17 + b) * 9216 + gq * 64 + ln] = s + ab[gq * 64 + ln]; }
                __syncthreads();
            }
        }
        __syncthreads();
        LAS float* scr = (LAS float*)(lds + wave * 16384);
        constexpr int IT_G = 16 * 88, IT_D = 44 * 32, IT_WIN0 = 16 * 37, IT_WQB = 4 * 24, IT_WKVB = 2 * 32, IT_WOUT = 16 * 32, IT_WIN1 = 16 * 96;
        constexpr int NITEMS = 8 * IT_G + 4 * IT_D + IT_WIN0 + IT_WQB + IT_WKVB + 2 * IT_WOUT + IT_WIN1;
        for (int it = gw; it < NITEMS; it += NGW) {
            int r = it;
            if (r < 8 * IT_G) { const int mi = r / IT_G; r -= mi * IT_G; const int l = mi >> 2, s = (mi >> 1) & 1, gu = mi & 1;
                const float* src = (l ? (gu ? IN(25) : IN(24)) : (gu ? IN(8) : IN(7))) + (size_t)s * 1024 * 2816;
                conv_item(src, 1024, 2816, W + WO_GU + (size_t)(l * 2 + s) * SZ_GU, 1 + gu, scr, r, lane); continue; }
            r -= 8 * IT_G;
            if (r < 4 * IT_D) { const int mi = r / IT_D; r -= mi * IT_D; const int l = mi >> 1, s = mi & 1;
                const float* src = (l ? IN(26) : IN(9)) + (size_t)s * 2816 * 1024;
                conv_item(src, 2816, 1024, W + WO_WD + (size_t)(l * 2 + s) * SZ_WD, 0, scr, r, lane); continue; }
            r -= 4 * IT_D;
            if (r < IT_WIN0) { conv_item(IN(10), 1024, 1184, W + WO_WIN0, 0, scr, r, lane); continue; } r -= IT_WIN0;
            if (r < IT_WQB) { conv_item(IN(12), 256, 768, W + WO_WQB, 0, scr, r, lane); continue; } r -= IT_WQB;
            if (r < IT_WKVB) { conv_item(IN(14), 128, 1024, W + WO_WKVB, 0, scr, r, lane); continue; } r -= IT_WKVB;
            if (r < IT_WOUT) { conv_item(IN(20), 1024, 1024, W + WO_WOUT0, 0, scr, r, lane); continue; } r -= IT_WOUT;
            if (r < IT_WIN1) { conv_item(IN(27), 1024, 3072, W + WO_WIN1, 3, scr, r, lane); continue; } r -= IT_WIN1;
            conv_item(IN(35), 1024, 1024, W + WO_WOUT1, 0, scr, r, lane);
        }
    }
    cg::this_grid().sync();
    { PHASE_IDS0(); if (tid == 0) (void)xb_add((unsigned*)(ws + WS_BAR) + XB_XCNT(xb_xcc_id()), 1u); }

#pragma nounroll
    for (int step = 0; step < 4; ++step) {
        const int l = step >> 1, s = step & 1;

        if (s == 1) {
            { PHASE_IDS(); norm_phase(HL, true, l ? (const void*)HCh : (const void*)IN(2), l != 0, MT, ng + 1024, modl, 1, A, gw, NGW, lane, (const _Float16*)(ws + WS_PART), HCh); }
            GRID_BAR();
            if (l == 0) {   PHASE_IDS();
                pg8::Gemm g{A, W + WO_WIN0, MT, P0W, 1024, 1024}; pg8::StaticOrder S; S.init(MT, P0W, G, bid);
                pg8::EpiStoreBf16 E{P0, P0P};
                pg8::gemm_phase<pg8::EpiStoreBf16, pg8::StaticOrder, true, true>(lds, g, S, E, tid);
            } else {        PHASE_IDS();
                pg8::Gemm g{A, W + WO_WIN1, MT, P1W, 1024, 1024}; pg8::StaticOrder S; S.init(MT, P1W, G, bid);
                pg8::EpiQKV1 E{P1, P1P, IN(28), IN(29), cos64, sin64, ML / 256, 0.125f * LOG2E, EPS};
                pg8::gemm_phase<pg8::EpiQKV1, pg8::StaticOrder, true, true>(lds, g, S, E, tid);
            }
            GRID_BAR();
            if (l == 0) {
                { PHASE_IDS();
                for (int row = gw; row < MT; row += NGW) {
                    bf16_t* p = P0 + (size_t)row * P0P; const bool lat = row < ML; const int t = row & 2047; const int sub = lane & 7;
                    bf16_t* hq = p + 416 + (lane >> 3) * 64; bf16_t* hk = p + 928 + ((lane >> 3) & 1) * 64;
                    const u32x2 w = *(const u32x2*)(p + 4 * lane); const unsigned wv = *(const unsigned*)(p + 256 + 2 * lane);
                    const u32x2 q1 = *(const u32x2*)(hq + 4 * sub), q2 = *(const u32x2*)(hq + 32 + 4 * sub), k1 = *(const u32x2*)(hk + 4 * sub), k2 = *(const u32x2*)(hk + 32 + 4 * sub);
                    { const float x0 = bflo(w.x), x1 = bfhi(w.x), x2 = bflo(w.y), x3 = bfhi(w.y);
                      const float ss = wave_sum((x0 * x0 + x1 * x1) + (x2 * x2 + x3 * x3), lane); const float r = 1.0f / sqrtf(ss * (1.0f / 256.0f) + EPS); const f32x4 gq = *(const f32x4*)(IN(11) + 4 * lane);
                      u32x2 o; o.x = pk_bf16(x0 * r * gq.x, x1 * r * gq.y); o.y = pk_bf16(x2 * r * gq.z, x3 * r * gq.w); *(u32x2*)(p + 4 * lane) = o; }
                    { const float x0 = bflo(wv), x1 = bfhi(wv);
                      const float ss = wave_sum(x0 * x0 + x1 * x1, lane); const float r = 1.0f / sqrtf(ss * (1.0f / 128.0f) + EPS);
                      *(unsigned*)(p + 256 + 2 * lane) = pk_bf16(x0 * r * IN(13)[2 * lane], x1 * r * IN(13)[2 * lane + 1]); }
                    head_nr64(lane, hq, q1, q2, sub, IN(17), lat, t, cos64, sin64, 0.125f * LOG2E, true);
                    head_nr64(lane, hk, k1, k2, sub, IN(18), lat, t, cos64, sin64, 1.0f, lane < 16);
                } }
                GRID_BAR();
                {   PHASE_IDS(); pg8::Gemm g{P0, W + WO_WQB, MT, 768, 256, P0P}; pg8::StaticOrder S; S.init(MT, 768, G, bid);
                    pg8::EpiStoreBf16 E{Qf, 768};
                    pg8::gemm_phase<pg8::EpiStoreBf16, pg8::StaticOrder, true, true>(lds, g, S, E, tid); }
                {   PHASE_IDS(); pg8::Gemm g{P0 + 256, W + WO_WKVB, MT, 1024, 128, P0P}; pg8::StaticOrder S; S.init(MT, 1024, G, bid);
                    pg8::EpiStoreBf16 E{KVf, KVP};
                    pg8::gemm_phase<pg8::EpiStoreBf16, pg8::StaticOrder, true, true>(lds, g, S, E, tid); }
                GRID_BAR();
                { PHASE_IDS();
                for (int row = gw; row < MT; row += NGW) {
                    const bool lat = row < ML; const int t = row & 2047; const int hd = lane >> 3, sub = lane & 7;
                    bf16_t* qp = Qf + (size_t)row * 768 + hd * 96; const bf16_t* kvp = KVf + (size_t)row * KVP + hd * 128; const bf16_t* krp = P0 + (size_t)row * P0P + 384;
                    const u32x4 wnq = *(const u32x4*)(qp + 8 * sub); const unsigned waq = *(const unsigned*)(qp + 64 + 2 * sub), wbq = *(const unsigned*)(qp + 80 + 2 * sub);
                    const u32x4 wnk = *(const u32x4*)(kvp + 8 * sub); const unsigned wak = *(const unsigned*)(krp + 2 * sub), wbk = *(const unsigned*)(krp + 16 + 2 * sub);
                    head_nr96(lane, wnq, waq, wbq, qp, sub, IN(15), lat, t, cos32, sin32, 0.10206207261596575f * LOG2E);
                    head_nr96(lane, wnk, wak, wbk, MK + (size_t)row * MKP + hd * 96, sub, IN(16), lat, t, cos32, sin32, 1.0f);
                } }
                GRID_BAR();
                { PHASE_IDS();
                for (int rep_ = 0; rep_ < REP_ATT0; ++rep_)
                for (int u = ((G & 7) == 0 ? (bid & 7) * (G >> 3) + (bid >> 3) : bid); u < 1024 + 128 + 1152; u += G) {

                    const int r = lane & 31, hh = lane >> 5;
                    if (u < 1024 + 128) {
                        int b, h, qrow0, nt;
                        if (u < 1024) { b = u >> 6; h = (u >> 3) & 7; qrow0 = b * 2048 + 256 * (u & 7); nt = 36; }
                        else { const int v = u - 1024; b = v >> 3; h = v & 7; qrow0 = ML + b * 256; nt = 4; }
                        const int qrow = qrow0 + 32 * wave + r;
                        bf16x8 qf[6];
#pragma unroll
                        for (int d0 = 0; d0 < 6; ++d0) qf[d0] = *(const bf16x8*)(Qf + (size_t)qrow * 768 + h * 96 + 16 * d0 + 8 * hh);
                        f32x16 o[2];
#pragma unroll
                        for (int i = 0; i < 16; ++i) { o[0][i] = 0.f; o[1][i] = 0.f; }
                        float m, lsum;
                        attn_run<96, 64, 96, false>(lds, tid, MK + h * 96, MKP, KVf + h * 128 + 64, KVP, ML + b * 256, b * 2048, nt, qf, 0, 0, 0, false, o, m, lsum);
                        write_o<2>(lane, o, lsum, m, false, 0.f, A + (size_t)(qrow - r) * 1024 + h * 64, hh, lds + 65536 + wave * 4608);
                    } else {
                        const int v = u - 1152; const int b = v / 72, kvh = (v / 36) & 1, qb = v % 36;
                        const bool isctx = qb < 4; const int q0l = isctx ? 0 : 64 * (qb - 4);
                        const int hq = kvh * 4 + (wave >> 1), qloc = 32 * (wave & 1) + r;
                        const int qrow = (isctx ? ML + b * 256 + 64 * qb : b * 2048 + q0l) + qloc;
                        int lat0 = 0, nt = 4;
                        if (!isctx) { lat0 = q0l - 128 > 0 ? q0l - 128 : 0; const int last = q0l + 192 < 2048 ? q0l + 192 : 2048; nt = 4 + (last - lat0) / 64; }
                        bf16x8 qf[4];
#pragma unroll
                        for (int d0 = 0; d0 < 4; ++d0) qf[d0] = *(const bf16x8*)(P0 + (size_t)qrow * P0P + 416 + hq * 64 + 16 * d0 + 8 * hh);
                        f32x16 o[2];
#pragma unroll
                        for (int i = 0; i < 16; ++i) { o[0][i] = 0.f; o[1][i] = 0.f; }
                        float m, lsum;
                        attn_run<64, 64, 64, true>(lds, tid, P0 + 928 + kvh * 64, P0P, P0 + 1056 + kvh * 64, P0P, ML + b * 256, b * 2048 + lat0, nt, qf, 0, q0l + qloc, lat0, false, o, m, lsum);
                        write_o<2>(lane, o, lsum, m, true, IN(19)[hq] * LOG2E, A + (size_t)(qrow - r) * 1024 + 512 + hq * 64, hh, lds + 65536 + wave * 4608);
                    }
                } }
            } else {
                { PHASE_IDS();
                const float lam = __expf(wave_sum(IN(30)[lane] * IN(31)[lane], lane)) - __expf(wave_sum(IN(32)[lane] * IN(33)[lane], lane)) + LAMBDA_INIT;
                for (int rep_ = 0; rep_ < REP_ATT1; ++rep_)
                for (int u = ((G & 7) == 0 ? (bid & 7) * (G >> 3) + (bid >> 3) : bid); u < 2048; u += G) {

                    const int r = lane & 31, hh = lane >> 5;
                    const int b = u >> 7, h = (u >> 4) & 7, qb = u & 15, mm = wave >> 2;
                    const int qrow = b * 2048 + 128 * qb + 32 * (wave & 3) + r;
                    bf16x8 qf[4];
#pragma unroll
                    for (int d0 = 0; d0 < 4; ++d0) qf[d0] = *(const bf16x8*)(P1 + (size_t)qrow * P1P + h * 128 + mm * 64 + 16 * d0 + 8 * hh);
                    f32x16 o[4];
#pragma unroll
                    for (int db = 0; db < 4; ++db)
#pragma unroll
                        for (int i = 0; i < 16; ++i) o[db][i] = 0.f;
                    float m, lsum;
                    attn_run<64, 128, 128, false>(lds, tid, P1 + 1024 + h * 128, P1P, P1 + 2048 + h * 128, P1P, ML + b * 256, b * 2048, 36, qf, mm * 128, 0, 0, false, o, m, lsum);
                    const float inv = 1.0f / (lsum + shx(lsum, 32, lane));
                    LAS float* stage = (LAS float*)lds + ((wave & 3) * 64) * 64 + lane;
                    asm volatile("" : "+v"(stage));
                    if (mm == 1) {
#pragma unroll
                        for (int db = 0; db < 4; ++db)
#pragma unroll
                            for (int i = 0; i < 16; ++i) stage[(db * 16 + i) * 64] = o[db][i] * inv;
                    }
                    __syncthreads();
                    if (mm == 0) {
                        float ss = 0.f;
#pragma unroll
                        for (int db = 0; db < 4; ++db)
#pragma unroll
                            for (int i = 0; i < 16; ++i) { const float x = o[db][i] * inv - lam * stage[(db * 16 + i) * 64]; o[db][i] = x; ss += x * x; }
                        ss += shx(ss, 32, lane);
                        const float rr = (1.0f - LAMBDA_INIT) / sqrtf(ss * (1.0f / 128.0f) + EPS);
                        LAS unsigned char* stg = lds + 96256 + wave * 8704;
                        LAS unsigned char* wp = stg + r * 272 + 8 * hh;
#pragma unroll
                        for (int db = 0; db < 4; ++db)
#pragma unroll
                            for (int g4 = 0; g4 < 4; ++g4) { const int d = 32 * db + 8 * g4 + 4 * hh; const f32x4 sg = *(const f32x4*)(IN(34) + d);
                                u32x2 w; w.x = pk_bf16(o[db][4 * g4] * rr * sg.x, o[db][4 * g4 + 1] * rr * sg.y); w.y = pk_bf16(o[db][4 * g4 + 2] * rr * sg.z, o[db][4 * g4 + 3] * rr * sg.w);
                                *(LAS u32x2*)(wp + 64 * db + 16 * g4) = w; }
                        asm volatile("s_waitcnt lgkmcnt(0)" ::: "memory");
                        bf16_t* obase = A + (size_t)(qrow - r) * 1024 + h * 128;
#pragma unroll
                        for (int i = 0; i < 8; ++i) { const int c = i * 64 + lane, row = c >> 4, ch = c & 15;
                            const u32x4 v = *(const LAS u32x4*)(stg + row * 272 + ch * 16); *(u32x4*)(obase + (size_t)row * 1024 + ch * 8) = v; }
                        asm volatile("s_waitcnt lgkmcnt(0)" ::: "memory");
                    }
                    __syncthreads();
                } }
            }
            GRID_BAR();
            {   PHASE_IDS();
                const int M = l ? ML : MT;
                pg8::Gemm g{A, W + (l ? WO_WOUT1 : WO_WOUT0), M, 1024, 1024, 1024}; pg8::SplitCtxOrder S; S.init(ML, 1024, G, bid, 16, l == 0);
                pg8::EpiResidPart<true, true> E{HL, HL, (_Float16*)(ws + WS_PART), modl + 5 * 1024, 1.0f, ML / 256};
                pg8::gemm_phase<pg8::EpiResidPart<true, true>, pg8::SplitCtxOrder, true, true>(lds, g, S, E, tid);
            }
            GRID_BAR();
        }
        const int Mf = (step == 3) ? ML : MT;
        {
#define NLNC() const void* nl = (step == 0) ? (const void*)IN(0) : (const void*)HL; const void* nc = (step == 0) ? (const void*)IN(2) : (const void*)HCh
            for (int rep_ = 0; rep_ < REP_NORM; ++rep_) { PHASE_IDS(); NLNC(); norm_phase(nl, step != 0, nc, step != 0, Mf, ng + (s ? 2048 : 0), modl, s ? 2 : 0, A, gw, NGW, lane, (step == 1 || step == 2) ? (const _Float16*)(ws + WS_PART) : (const _Float16*)nullptr, HCh); }
            GRID_BAR();
            {   PHASE_IDS(); pg8::Gemm g{A, W + WO_GU + (size_t)step * SZ_GU, Mf, 5632, 1024, 1024}; pg8::StaticOrder S; S.init(Mf, 5632, G, bid);
                pg8::EpiSwiglu E{U, DFF};
                for (int rep_ = 0; rep_ < REP_GU; ++rep_) pg8::gemm_phase<pg8::EpiSwiglu, pg8::StaticOrder, true, true>(lds, g, S, E, tid); }
            GRID_BAR();
            {   PHASE_IDS(); NLNC(); pg8::Gemm g{U, W + WO_WD + (size_t)step * SZ_WD, Mf, 1024, DFF, DFF}; pg8::SplitCtxOrder S; S.init(ML, 1024, G, bid, DFF / 64, step < 3);
                (void)nc; _Float16* partp = (_Float16*)(ws + WS_PART); const float* gatep = modl + (s ? 8 : 2) * 1024;
                if (step == 0) { pg8::EpiResidPart<false, true> E{nl, HL, partp, gatep, 0.5f, ML / 256}; pg8::gemm_phase<pg8::EpiResidPart<false, true>, pg8::SplitCtxOrder, true, true>(lds, g, S, E, tid); }
                else if (step == 3) { pg8::EpiResidPart<true, false> E{nl, OUT, partp, gatep, 0.5f, ML / 256}; pg8::gemm_phase<pg8::EpiResidPart<true, false>, pg8::SplitCtxOrder, true, true>(lds, g, S, E, tid); }
                else { pg8::EpiResidPart<true, true> E{nl, HL, partp, gatep, 0.5f, ML / 256}; pg8::gemm_phase<pg8::EpiResidPart<true, true>, pg8::SplitCtxOrder, true, true>(lds, g, S, E, tid); } }
            if (step < 3) GRID_BAR();
            for (int rep_ = 0; rep_ < REP_SYNC; ++rep_) GRID_BAR();
        }
    }
#undef IN
}

extern "C" void kernel_launch(void* const* d_in, const int* in_sizes, int n_in, void* d_out, int out_size, void* d_ws, size_t ws_size, hipStream_t stream) {
    static int grid_blocks = 0;
    if (grid_blocks == 0) {
        if (n_in != 36 || ws_size < WS_END) { fprintf(stderr, "kernel_launch: unexpected n_in %d / ws_size %zu\n", n_in, ws_size); grid_blocks = -1; return; }
        int dev = 0, cus = 0, per_cu = 0;
        hipGetDevice(&dev);
        hipDeviceGetAttribute(&cus, hipDeviceAttributeMultiprocessorCount, dev);
        hipFuncSetAttribute((const void*)fwd_megakernel, hipFuncAttributeMaxDynamicSharedMemorySize, LDS_BYTES);
        hipOccupancyMaxActiveBlocksPerMultiprocessor(&per_cu, (const void*)fwd_megakernel, 512, LDS_BYTES);
        if (per_cu < 1) per_cu = 1;
        grid_blocks = cus * per_cu;
        (void)hipGetLastError();
    }
    if (grid_blocks < 0) return;
    Args a{};
    for (int i = 0; i < 36; ++i) a.in[i] = (const float*)d_in[i];
    a.out = (float*)d_out; a.ws = (unsigned char*)d_ws;
    void* args[] = {&a};
    hipError_t e = hipLaunchCooperativeKernel((const void*)fwd_megakernel, dim3(grid_blocks), dim3(512), args, LDS_BYTES, stream);
    if (e != hipSuccess) fprintf(stderr, "cooperative launch failed: %s (grid %d)\n", hipGetErrorString(e), grid_blocks);
}
```

```cpp
#include <hip/hip_runtime.h>
#include <hip/hip_cooperative_groups.h>
#include <cstdio>
#include <cstdint>
namespace cg = cooperative_groups;
#pragma clang fp reassociate(on)
namespace pg8 {
#define PG8_LAS __attribute__((address_space(3)))
typedef unsigned short bf16_t;
typedef short bf16x8 __attribute__((ext_vector_type(8)));
typedef float f32x4 __attribute__((ext_vector_type(4)));
typedef unsigned u32x4 __attribute__((ext_vector_type(4)));
constexpr int BM = 256, BK = 64, HALF = 128, HTB = HALF * BK * 2  , STAGE_BYTES = 8 * HTB, NXCD = 8, WGM = 8;

__host__ __device__ __forceinline__ int lds_byte(int r, int c) { const int st = (r >> 4) * 2 + (c >> 5), rr = r & 15, cc = c & 31, ob = rr * 64 + cc * 2; return st * 1024 + (ob ^ (((ob >> 9) & 1) << 5)); }
__host__ __device__ __forceinline__ void stage_rc(int b, int& R, int& C) { const int st = b / 1024, sb = b % 1024, swz = sb ^ (((sb >> 9) & 1) << 5); R = (st >> 1) * 16 + swz / 64; C = (st & 1) * 32 + (swz % 64) / 2; }
__host__ __device__ __forceinline__ int perm32(int rho) { const int n = rho >> 4, i = rho & 15; return 8 * (i >> 2) + 4 * n + (i & 3); }

struct Unit { int pm, pn, kinfo; };
struct Gemm { const bf16_t* A; const bf16_t* Bt; int M, N, K, lda; };

struct StaticOrder {
    int nM, nN, nwg, G, c;
    __host__ __device__ void init(int M, int N, int G_, int c_) { nM = M / BM; nN = N / BM; nwg = nM * nN; G = G_; c = c_; }
    __host__ __device__ bool next(int i, Unit& u) const {
        const long L = (long)i * G + c; if (L >= nwg) return false;
        int wgid = (int)L; { const int q = nwg / NXCD, r = nwg % NXCD, xcd = wgid % NXCD, off = wgid / NXCD; wgid = (xcd < r ? xcd * (q + 1) : r * (q + 1) + (xcd - r) * q) + off; }
        const int nig = WGM * nN, gid = wgid / nig, fm = gid * WGM, gsz = (nM - fm) < WGM ? (nM - fm) : WGM;
        u.pm = fm + ((wgid % nig) % gsz); u.pn = (wgid % nig) / gsz; u.kinfo = 0; return true;
    }
    __device__ __forceinline__ void a_ready(const Unit&) const {}
    __device__ __forceinline__ void done(const Unit&) const {}
};


struct SplitCtxOrder {
    StaticOrder lat; int nmine, nN_, G_, c_, nkA, nkB, nparts;
    __host__ __device__ void init(int Mlat, int N, int G, int c, int ntK, bool with_ctx) { lat.init(Mlat, N, G, c); nmine = c < lat.nwg ? (lat.nwg - c + G - 1) / G : 0; nN_ = N / BM; G_ = G; c_ = c;
        nkA = ((ntK / 4 + 1) / 2) * 2; nkB = (ntK - 2 * nkA) / 2; nparts = with_ctx ? 16 * nN_ * 4 : 0; }
    __host__ __device__ bool next(int i, Unit& u) const {
        if (i < nmine) return lat.next(i, u);
        const int idx = (i - nmine) * G_ + c_; if (idx >= nparts) return false;
        const int kp = idx & 3, tile = idx >> 2;
        u.pm = lat.nM + tile / nN_; u.pn = tile % nN_;
        const int k0 = kp < 2 ? kp * nkA : 2 * nkA + (kp - 2) * nkB, nk = kp < 2 ? nkA : nkB; u.kinfo = k0 | (nk << 8) | (kp << 16); return true;
    }
    __device__ __forceinline__ void a_ready(const Unit&) const {}
    __device__ __forceinline__ void done(const Unit&) const {}
};
__device__ __forceinline__ unsigned cvt_pk_bf16(float lo, float hi) { unsigned r; asm volatile("v_cvt_pk_bf16_f32 %0, %1, %2" : "=v"(r) : "v"(lo), "v"(hi)); return r; }
typedef float f32x2 __attribute__((ext_vector_type(2)));
__device__ __forceinline__ unsigned pk_bf16(float lo, float hi) { typedef __bf16 b2_t __attribute__((ext_vector_type(2))); f32x2 v = {lo, hi}; b2_t b = __builtin_convertvector(v, b2_t); return __builtin_bit_cast(unsigned, b); }
__device__ __forceinline__ float silu_f(float x) { return x * __builtin_amdgcn_rcpf(1.0f + __builtin_amdgcn_exp2f(-1.4426950408889634f * x)); }

struct EpiStoreBf16 {
    static constexpr bool PERM = true, AFTER_DRAIN = false;
    bf16_t* O; int ldc;
    __device__ __forceinline__ void operator()(const f32x4 (&acc)[2][2][4][2], const Unit& u, int wr, int wc, int fr, int fq) const {
        const int row0 = u.pm * BM + wr * 64 + fr, col0 = u.pn * BM + wc * 32 + 8 * fq;
#pragma unroll
        for (int ai = 0; ai < 2; ++ai)
#pragma unroll
            for (int m = 0; m < 4; ++m) { bf16_t* rowp = O + (size_t)(row0 + ai * HALF + m * 16) * ldc + col0;
#pragma unroll
                for (int bj = 0; bj < 2; ++bj) { const f32x4 v0 = acc[ai][bj][m][0], v1 = acc[ai][bj][m][1];
                    u32x4 w; w.x = pk_bf16(v0[0], v0[1]); w.y = pk_bf16(v0[2], v0[3]); w.z = pk_bf16(v1[0], v1[1]); w.w = pk_bf16(v1[2], v1[3]);
                    *(u32x4*)(rowp + bj * HALF) = w; } }
    }
};
struct EpiSwiglu {
    static constexpr bool PERM = true, AFTER_DRAIN = false;
    bf16_t* U; int ldu;
    __device__ __forceinline__ void operator()(const f32x4 (&acc)[2][2][4][2], const Unit& u, int wr, int wc, int fr, int fq) const {
        const int row0 = u.pm * BM + wr * 64 + fr, col0 = u.pn * HALF + wc * 32 + 8 * fq;
#pragma unroll
        for (int ai = 0; ai < 2; ++ai)
#pragma unroll
            for (int m = 0; m < 4; ++m) { bf16_t* rowp = U + (size_t)(row0 + ai * HALF + m * 16) * ldu + col0;
                const f32x4 g0 = acc[ai][0][m][0], g1 = acc[ai][0][m][1], u0 = acc[ai][1][m][0], u1 = acc[ai][1][m][1];
                u32x4 w;
                w.x = pk_bf16(silu_f(g0[0]) * u0[0], silu_f(g0[1]) * u0[1]); w.y = pk_bf16(silu_f(g0[2]) * u0[2], silu_f(g0[3]) * u0[3]);
                w.z = pk_bf16(silu_f(g1[0]) * u1[0], silu_f(g1[1]) * u1[1]); w.w = pk_bf16(silu_f(g1[2]) * u1[2], silu_f(g1[3]) * u1[3]);
                *(u32x4*)rowp = w; }
    }
};
struct EpiResid {
    static constexpr bool PERM = false, AFTER_DRAIN = false;
    const float* base_lat; const float* base_ctx; float* out_lat; float* out_ctx; const float* gate; float gs;
    __device__ __forceinline__ void operator()(const f32x4 (&acc)[2][2][4][2], const Unit& u, int wr, int wc, int fr, int fq) const {
        const bool isctx = u.pm >= 128; const int bidx = isctx ? 16 : (u.pm >> 3);
        const float* base = isctx ? base_ctx : base_lat; float* out = isctx ? out_ctx : out_lat;
        const int rloc = (isctx ? (u.pm - 128) : u.pm) * BM + wr * 64 + fr, col0 = u.pn * BM + wc * 32 + 4 * fq;
        f32x4 gv[2][2];
#pragma unroll
        for (int bj = 0; bj < 2; ++bj)
#pragma unroll
            for (int n = 0; n < 2; ++n) gv[bj][n] = *(const f32x4*)(gate + (size_t)bidx * 9216 + col0 + bj * HALF + n * 16) * gs;
#pragma unroll
        for (int ai = 0; ai < 2; ++ai)
#pragma unroll
            for (int m = 0; m < 4; ++m) { const size_t off = (size_t)(rloc + ai * HALF + m * 16) * 1024 + col0;
#pragma unroll
                for (int bj = 0; bj < 2; ++bj)
#pragma unroll
                    for (int n = 0; n < 2; ++n) { const f32x4 b = *(const f32x4*)(base + off + bj * HALF + n * 16);
                        *(f32x4*)(out + off + bj * HALF + n * 16) = b + gv[bj][n] * acc[ai][bj][m][n]; } }
    }
};

typedef _Float16 f16x8 __attribute__((ext_vector_type(8)));
typedef _Float16 f16x4 __attribute__((ext_vector_type(4)));
template <bool BASE16, bool OUT16> struct EpiResidPart {
    static constexpr bool PERM = true, AFTER_DRAIN = false;
    const void* base_lat; void* out_lat; _Float16* part; const float* gate; float gs; int nMlat;
    __device__ __forceinline__ void operator()(const f32x4 (&acc)[2][2][4][2], const Unit& u, int wr, int wc, int fr, int fq) const {
        const bool isctx = u.pm >= nMlat; const int bidx = isctx ? 16 : (u.pm >> 3);
        const int rloc = (isctx ? (u.pm - nMlat) : u.pm) * BM + wr * 64 + fr, col0 = u.pn * BM + wc * 32 + 8 * fq;
        f32x4 gv[2][2];
#pragma unroll
        for (int bj = 0; bj < 2; ++bj)
#pragma unroll
            for (int n = 0; n < 2; ++n) gv[bj][n] = *(const f32x4*)(gate + (size_t)bidx * 9216 + col0 + bj * HALF + n * 4) * gs;
        if (!isctx) {
#pragma unroll
            for (int ai = 0; ai < 2; ++ai) {
                f32x4 pre[4][2][2];
#pragma unroll
                for (int m = 0; m < 4; ++m) { const size_t off = (size_t)(rloc + ai * HALF + m * 16) * 1024 + col0;
#pragma unroll
                    for (int bj = 0; bj < 2; ++bj) {
                        if (BASE16) { const f16x8 hb = *(const f16x8*)((const _Float16*)base_lat + off + bj * HALF);
                            pre[m][bj][0] = (f32x4){(float)hb[0], (float)hb[1], (float)hb[2], (float)hb[3]}; pre[m][bj][1] = (f32x4){(float)hb[4], (float)hb[5], (float)hb[6], (float)hb[7]}; }
                        else { pre[m][bj][0] = *(const f32x4*)((const float*)base_lat + off + bj * HALF); pre[m][bj][1] = *(const f32x4*)((const float*)base_lat + off + bj * HALF + 4); } } }
                asm volatile("" ::: "memory");
#pragma unroll
                for (int m = 0; m < 4; ++m) { const size_t off = (size_t)(rloc + ai * HALF + m * 16) * 1024 + col0;
#pragma unroll
                    for (int bj = 0; bj < 2; ++bj) { const f32x4 o0 = pre[m][bj][0] + gv[bj][0] * acc[ai][bj][m][0], o1 = pre[m][bj][1] + gv[bj][1] * acc[ai][bj][m][1];
                        if (OUT16) { f16x8 ho; ho[0] = (_Float16)o0[0]; ho[1] = (_Float16)o0[1]; ho[2] = (_Float16)o0[2]; ho[3] = (_Float16)o0[3]; ho[4] = (_Float16)o1[0]; ho[5] = (_Float16)o1[1]; ho[6] = (_Float16)o1[2]; ho[7] = (_Float16)o1[3];
                            *(f16x8*)((_Float16*)out_lat + off + bj * HALF) = ho; }
                        else { *(f32x4*)((float*)out_lat + off + bj * HALF) = o0; *(f32x4*)((float*)out_lat + off + bj * HALF + 4) = o1; } } }
                asm volatile("" ::: "memory");
            }
        } else {
            _Float16* pp = part + (size_t)(u.kinfo >> 16) * (4096 * 1024);
#pragma unroll
            for (int ai = 0; ai < 2; ++ai)
#pragma unroll
                for (int m = 0; m < 4; ++m) { const size_t off = (size_t)(rloc + ai * HALF + m * 16) * 1024 + col0;
#pragma unroll
                    for (int bj = 0; bj < 2; ++bj) { const f32x4 p0 = gv[bj][0] * acc[ai][bj][m][0], p1 = gv[bj][1] * acc[ai][bj][m][1];
                        f16x8 hp; hp[0] = (_Float16)p0[0]; hp[1] = (_Float16)p0[1]; hp[2] = (_Float16)p0[2]; hp[3] = (_Float16)p0[3]; hp[4] = (_Float16)p1[0]; hp[5] = (_Float16)p1[1]; hp[6] = (_Float16)p1[2]; hp[7] = (_Float16)p1[3];
                        *(f16x8*)(pp + off + bj * HALF) = hp; } }
        }
    }
};

struct EpiQKV1 {
    static constexpr bool PERM = true, AFTER_DRAIN = false;
    bf16_t* P; int ldp; const float* qg; const float* kg; const float* cs; const float* sn; int nMlat; float qscale, eps;
    __device__ __forceinline__ void operator()(const f32x4 (&acc)[2][2][4][2], const Unit& u, int wr, int wc, int fr, int fq) const {
        const int row0 = u.pm * BM + wr * 64 + fr, colb = u.pn * BM + wc * 64 + 8 * fq;
        if (u.pn >= 8) {
#pragma unroll
            for (int ai = 0; ai < 2; ++ai)
#pragma unroll
                for (int m = 0; m < 4; ++m) { bf16_t* rowp = P + (size_t)(row0 + ai * HALF + m * 16) * ldp + colb;
#pragma unroll
                    for (int bj = 0; bj < 2; ++bj) { const f32x4 v0 = acc[ai][bj][m][0], v1 = acc[ai][bj][m][1];
                        u32x4 w; w.x = pk_bf16(v0[0], v0[1]); w.y = pk_bf16(v0[2], v0[3]); w.z = pk_bf16(v1[0], v1[1]); w.w = pk_bf16(v1[2], v1[3]);
                        *(u32x4*)(rowp + 32 * bj) = w; } }
            return;
        }
        const bool isq = u.pn < 4, lat = u.pm < nMlat; const float* g = isq ? qg : kg; const float osc = isq ? qscale : 1.0f;
        f32x4 g1[2], g2[2];
#pragma unroll
        for (int n = 0; n < 2; ++n) { g1[n] = *(const f32x4*)(g + 8 * fq + 4 * n) * osc; g2[n] = *(const f32x4*)(g + 32 + 8 * fq + 4 * n) * osc; }
        const int lane = fq * 16 + fr;
#pragma unroll
        for (int ai = 0; ai < 2; ++ai)
#pragma unroll
            for (int m = 0; m < 4; ++m) { const int row = row0 + ai * HALF + m * 16;
                const f32x4 a0 = acc[ai][0][m][0], a1 = acc[ai][0][m][1], b0 = acc[ai][1][m][0], b1 = acc[ai][1][m][1];
                float ss = ((a0[0] * a0[0] + a0[1] * a0[1]) + (a0[2] * a0[2] + a0[3] * a0[3])) + ((a1[0] * a1[0] + a1[1] * a1[1]) + (a1[2] * a1[2] + a1[3] * a1[3]))
                         + ((b0[0] * b0[0] + b0[1] * b0[1]) + (b0[2] * b0[2] + b0[3] * b0[3])) + ((b1[0] * b1[0] + b1[1] * b1[1]) + (b1[2] * b1[2] + b1[3] * b1[3]));
                ss += __int_as_float(__builtin_amdgcn_ds_bpermute((lane ^ 16) << 2, __float_as_int(ss)));
                ss += __int_as_float(__builtin_amdgcn_ds_bpermute((lane ^ 32) << 2, __float_as_int(ss)));
                const float r = 1.0f / sqrtf(ss * (1.0f / 64.0f) + eps);
                f32x4 y10 = a0 * r * g1[0], y11 = a1 * r * g1[1], y20 = b0 * r * g2[0], y21 = b1 * r * g2[1];
                if (lat) { const int t = row & 2047;
                    const f32x4 c0 = *(const f32x4*)(cs + t * 32 + 8 * fq), c1 = *(const f32x4*)(cs + t * 32 + 8 * fq + 4), s0 = *(const f32x4*)(sn + t * 32 + 8 * fq), s1 = *(const f32x4*)(sn + t * 32 + 8 * fq + 4);
                    const f32x4 o10 = y10 * c0 - y20 * s0, o20 = y10 * s0 + y20 * c0, o11 = y11 * c1 - y21 * s1, o21 = y11 * s1 + y21 * c1;
                    y10 = o10; y20 = o20; y11 = o11; y21 = o21; }
                bf16_t* rowp = P + (size_t)row * ldp + colb;
                u32x4 w1; w1.x = pk_bf16(y10[0], y10[1]); w1.y = pk_bf16(y10[2], y10[3]); w1.z = pk_bf16(y11[0], y11[1]); w1.w = pk_bf16(y11[2], y11[3]);
                u32x4 w2; w2.x = pk_bf16(y20[0], y20[1]); w2.y = pk_bf16(y20[2], y20[3]); w2.z = pk_bf16(y21[0], y21[1]); w2.w = pk_bf16(y21[2], y21[3]);
                *(u32x4*)(rowp) = w1; *(u32x4*)(rowp + 32) = w2; }
    }
};

template <class Epi, class Sched, bool ALIGN_EPI = false, bool SP2 = false>
__device__ __forceinline__ void gemm_phase(PG8_LAS unsigned char* lds, const Gemm g, const Sched& S, const Epi& E, int tid_in) {
    const int tid = tid_in, wid = __builtin_amdgcn_readfirstlane(tid >> 6), lane = tid & 63, wr = wid >> 2, wc = wid & 3, fr = lane & 15, fq = lane >> 4;
    const int K = g.K, nt = K / BK;
    unsigned voffA[2], voffB[2];
#pragma unroll
    for (int i = 0; i < 2; ++i) { int R, C; stage_rc(tid * 16 + i * 8192, R, C); const int Rb = Epi::PERM ? ((R & ~31) + perm32(R & 31)) : R;
        voffA[i] = (unsigned)(R * g.lda + C) * 2u; voffB[i] = (unsigned)(Rb * K + C) * 2u; }
    const size_t kstep = (size_t)(BK * 2);
    const size_t hstepB = (size_t)HALF * K * 2, hstepA = (size_t)HALF * g.lda * 2;
    const size_t tstepA = 2 * hstepA, tstepB = 2 * hstepB;
    const unsigned ldsw = (unsigned)wid * 1024u;
    const int aoff = lds_byte(wr * 64 + fr, fq * 8), boff = lds_byte(wc * 32 + fr, fq * 8);
#define PG8_SA(b, h) (((b) * 2 + (h)) * HTB)
#define PG8_SB(b, h) ((4 + (b) * 2 + (h)) * HTB)
#define PG8_STAGE(bufoff, gbase, voff) do { _Pragma("unroll") for (int _i = 0; _i < 2; ++_i) \
        __builtin_amdgcn_global_load_lds((const unsigned*)((const char*)(gbase) + (voff)[_i]), (PG8_LAS unsigned*)(lds + (bufoff) + ldsw + _i * 8192), 16, 0, 0); } while (0)
#define PG8_LDA(dst, b, h) do { _Pragma("unroll") for (int m = 0; m < 4; ++m) _Pragma("unroll") for (int k = 0; k < 2; ++k) dst[m][k] = *(const PG8_LAS bf16x8*)(lds + PG8_SA(b, h) + aoff + m * 2048 + k * 1024); } while (0)
#define PG8_LDB(dst, b, h) do { _Pragma("unroll") for (int n = 0; n < 2; ++n) _Pragma("unroll") for (int k = 0; k < 2; ++k) dst[n][k] = *(const PG8_LAS bf16x8*)(lds + PG8_SB(b, h) + boff + n * 2048 + k * 1024); } while (0)
#define PG8_MMA(ai, bj, At, Bt) do { __builtin_amdgcn_s_setprio(1); _Pragma("unroll") for (int m = 0; m < 4; ++m) _Pragma("unroll") for (int n = 0; n < 2; ++n) _Pragma("unroll") for (int k = 0; k < 2; ++k) \
        acc[ai][bj][m][n] = __builtin_amdgcn_mfma_f32_16x16x32_bf16(Bt[n][k], At[m][k], acc[ai][bj][m][n], 0, 0, 0); __builtin_amdgcn_s_setprio(0); } while (0)
#define PG8_WAIT_V(n) asm volatile("s_waitcnt vmcnt(" #n ")" ::: "memory")
#define PG8_WAIT_L(n) asm volatile("s_waitcnt lgkmcnt(" #n ")" ::: "memory")
#define PG8_BAR __builtin_amdgcn_s_barrier()
#define PG8_SCHED __builtin_amdgcn_sched_barrier(0)
    Unit cur, nxt; int ui = 0;
    if (!S.next(0, cur)) return;
    f32x4 acc[2][2][4][2];
#pragma unroll
    for (int a = 0; a < 2; ++a)
#pragma unroll
        for (int b = 0; b < 2; ++b)
#pragma unroll
            for (int m = 0; m < 4; ++m)
#pragma unroll
                for (int n = 0; n < 2; ++n) acc[a][b][m][n] = (f32x4){0.f, 0.f, 0.f, 0.f};
    bf16x8 At[4][2], B0[2][2], B1[2][2];
    const char* cA = (const char*)g.A + (size_t)cur.pm * tstepA + (size_t)(cur.kinfo & 255) * kstep; const char* cB = (const char*)g.Bt + (size_t)cur.pn * tstepB + (size_t)(cur.kinfo & 255) * kstep;
    S.a_ready(cur);
    if constexpr (SP2) {
        PG8_STAGE(PG8_SB(0, 0), cB, voffB); PG8_STAGE(PG8_SB(0, 1), cB + hstepB, voffB); PG8_STAGE(PG8_SA(0, 0), cA, voffA); PG8_STAGE(PG8_SA(0, 1), cA + hstepA, voffA);
        if (wr == 1) PG8_BAR;
        PG8_WAIT_V(2); PG8_BAR;
        PG8_STAGE(PG8_SB(1, 0), cB + kstep, voffB); PG8_STAGE(PG8_SA(1, 0), cA + kstep, voffA); PG8_STAGE(PG8_SB(1, 1), cB + hstepB + kstep, voffB);
        PG8_WAIT_V(6); PG8_BAR;
    } else {
        PG8_STAGE(PG8_SB(0, 0), cB, voffB); PG8_STAGE(PG8_SA(0, 0), cA, voffA); PG8_STAGE(PG8_SB(0, 1), cB + hstepB, voffB); PG8_STAGE(PG8_SA(0, 1), cA + hstepA, voffA);
        if (wr == 1) PG8_BAR;
        PG8_WAIT_V(4); PG8_BAR;
        PG8_STAGE(PG8_SB(1, 0), cB + kstep, voffB); PG8_STAGE(PG8_SA(1, 0), cA + kstep, voffA); PG8_STAGE(PG8_SB(1, 1), cB + hstepB + kstep, voffB);
        PG8_WAIT_V(6); PG8_BAR;
    }
    for (;;) {
        const bool has_next = S.next(ui + 1, nxt);
        const char* nA = has_next ? (const char*)g.A + (size_t)nxt.pm * tstepA + (size_t)(nxt.kinfo & 255) * kstep : cA; const char* nB = has_next ? (const char*)g.Bt + (size_t)nxt.pn * tstepB + (size_t)(nxt.kinfo & 255) * kstep : cB;
        const int cnt_ = cur.kinfo ? ((cur.kinfo >> 8) & 255) : nt;
        for (int t = 0; t < cnt_; t += 2) {
            const bool last = (t == cnt_ - 2);
            const char* a1 = cA + (size_t)(t + 1) * kstep;
            const char* a2 = last ? nA : cA + (size_t)(t + 2) * kstep; const char* b2 = last ? nB : cB + (size_t)(t + 2) * kstep;
            const char* a3 = a2 + kstep; const char* b3 = b2 + kstep;
            if (last && has_next) S.a_ready(nxt);
            if constexpr (SP2) {
            PG8_LDB(B0, 0, 0); PG8_LDB(B1, 0, 1); PG8_SCHED; PG8_LDA(At, 0, 0); PG8_STAGE(PG8_SA(1, 1), a1 + hstepA, voffA);
            PG8_WAIT_V(8); PG8_WAIT_L(0); PG8_BAR; PG8_MMA(0, 0, At, B0); PG8_MMA(0, 1, At, B1); PG8_BAR; PG8_SCHED;
            PG8_LDA(At, 0, 1); PG8_STAGE(PG8_SB(0, 0), b2, voffB); PG8_STAGE(PG8_SB(0, 1), b2 + hstepB, voffB); PG8_STAGE(PG8_SA(0, 0), a2, voffA);
            PG8_WAIT_V(8); PG8_WAIT_L(0); PG8_BAR; PG8_MMA(1, 0, At, B0); PG8_MMA(1, 1, At, B1); PG8_BAR; PG8_SCHED;
            PG8_LDB(B0, 1, 0); PG8_LDB(B1, 1, 1); PG8_SCHED; PG8_LDA(At, 1, 0); PG8_STAGE(PG8_SA(0, 1), a2 + hstepA, voffA);
            PG8_WAIT_V(8); PG8_WAIT_L(0); PG8_BAR; PG8_MMA(0, 0, At, B0); PG8_MMA(0, 1, At, B1); PG8_BAR; PG8_SCHED;
            PG8_LDA(At, 1, 1); PG8_STAGE(PG8_SB(1, 0), b3, voffB); PG8_STAGE(PG8_SB(1, 1), b3 + hstepB, voffB); PG8_STAGE(PG8_SA(1, 0), a3, voffA);
            PG8_WAIT_V(8); PG8_WAIT_L(0); PG8_BAR; PG8_MMA(1, 0, At, B0); PG8_MMA(1, 1, At, B1); PG8_BAR; PG8_SCHED;
            } else {
            PG8_LDB(B0, 0, 0); PG8_SCHED; PG8_LDA(At, 0, 0); PG8_STAGE(PG8_SA(1, 1), a1 + hstepA, voffA);
            PG8_WAIT_L(8); PG8_BAR; PG8_WAIT_L(0); PG8_MMA(0, 0, At, B0); PG8_BAR; PG8_SCHED;
            PG8_LDB(B1, 0, 1); PG8_STAGE(PG8_SB(0, 0), b2, voffB);
            PG8_BAR; PG8_WAIT_L(0); PG8_MMA(0, 1, At, B1); PG8_BAR;
            PG8_LDA(At, 0, 1); PG8_STAGE(PG8_SA(0, 0), a2, voffA);
            PG8_BAR; PG8_WAIT_L(0); PG8_MMA(1, 0, At, B0); PG8_BAR; PG8_SCHED;
            PG8_STAGE(PG8_SB(0, 1), b2 + hstepB, voffB);
            PG8_WAIT_V(6); PG8_BAR; PG8_MMA(1, 1, At, B1); PG8_BAR;
            PG8_LDB(B0, 1, 0); PG8_SCHED; PG8_LDA(At, 1, 0); PG8_STAGE(PG8_SA(0, 1), a2 + hstepA, voffA);
            PG8_WAIT_L(8); PG8_BAR; PG8_WAIT_L(0); PG8_MMA(0, 0, At, B0); PG8_BAR; PG8_SCHED;
            PG8_LDB(B1, 1, 1); PG8_STAGE(PG8_SB(1, 0), b3, voffB);
            PG8_BAR; PG8_WAIT_L(0); PG8_MMA(0, 1, At, B1); PG8_BAR;
            PG8_LDA(At, 1, 1); PG8_STAGE(PG8_SA(1, 0), a3, voffA);
            PG8_BAR; PG8_WAIT_L(0); PG8_MMA(1, 0, At, B0); PG8_BAR; PG8_SCHED;
            PG8_STAGE(PG8_SB(1, 1), b3 + hstepB, voffB);
            PG8_WAIT_V(6); PG8_BAR; PG8_MMA(1, 1, At, B1); PG8_BAR;
            }
        }
        if constexpr (ALIGN_EPI) { if (wr == 0) PG8_BAR; }
        if constexpr (!Epi::AFTER_DRAIN) { E(acc, cur, wr, wc, fr, fq); S.done(cur); }
        if (!has_next) break;
#pragma unroll
        for (int a = 0; a < 2; ++a)
#pragma unroll
            for (int b = 0; b < 2; ++b)
#pragma unroll
                for (int m = 0; m < 4; ++m)
#pragma unroll
                    for (int n = 0; n < 2; ++n) acc[a][b][m][n] = (f32x4){0.f, 0.f, 0.f, 0.f};
        cur = nxt; cA = nA; cB = nB; ++ui;
        if constexpr (ALIGN_EPI) { if (wr == 1) PG8_BAR; }
    }
    PG8_WAIT_V(0);
    if constexpr (!ALIGN_EPI) { if (wr == 0) PG8_BAR; }
    PG8_BAR;
    if constexpr (Epi::AFTER_DRAIN) { E.fused(acc, cur, wr, wc, fr, fq, lds, wid, lane); S.done(cur); }
#undef PG8_SA
#undef PG8_SB
#undef PG8_STAGE
#undef PG8_LDA
#undef PG8_LDB
#undef PG8_MMA
#undef PG8_WAIT_V
#undef PG8_WAIT_L
#undef PG8_BAR
#undef PG8_SCHED
}
}

#define REP_ATT0 1
#define REP_ATT1 1
#define REP_GU 1
#define REP_NORM 1
#define REP_SYNC 0
#define LAS __attribute__((address_space(3)))
typedef unsigned short bf16_t;
typedef short bf16x8 __attribute__((ext_vector_type(8)));
typedef short s16x4 __attribute__((ext_vector_type(4)));
typedef short v4i16_t __attribute__((ext_vector_type(4)));
typedef float f32x16 __attribute__((ext_vector_type(16)));
typedef float f32x4 __attribute__((ext_vector_type(4)));
typedef unsigned u32x4 __attribute__((ext_vector_type(4)));
typedef unsigned u32x2 __attribute__((ext_vector_type(2)));
using pg8::pk_bf16;

constexpr int D = 1024, NB = 16, SEQ = 2048, CTX = 256, DFF = 2816;
constexpr int ML = NB * SEQ, MC = NB * CTX, MT = ML + MC;
constexpr int P0W = 1280, P1W = 3072;
constexpr int P0P = 1408, P1P = 3200, KVP = 1152, MKP = 896;
constexpr float EPS = 1e-6f, LOG2E = 1.4426950408889634f;
constexpr float LAMBDA_INIT = 0.35550906759096927f;
constexpr size_t MiB = 1u << 20;
constexpr size_t WS_MOD = 0;
constexpr size_t WS_ROPE = 2 * MiB;
constexpr size_t WS_BAR = 3 * MiB;
constexpr size_t WS_HC = 4 * MiB;
constexpr size_t WS_W = 20 * MiB;
constexpr size_t WS_HL = 100 * MiB, WS_HCH = 164 * MiB;
constexpr size_t WS_A = 100 * MiB;
constexpr size_t WS_P = 172 * MiB;
constexpr size_t WS_QF = 271 * MiB, WS_KVF = 325 * MiB;
constexpr size_t WS_MK = 406 * MiB;
constexpr size_t WS_PART = 400 * MiB;
constexpr size_t WS_END = 469 * MiB;
static_assert((size_t)MT * P0P * 2 <= 99 * MiB && (size_t)MT * KVP * 2 <= 81 * MiB && (size_t)MT * MKP * 2 <= 63 * MiB && (size_t)MT * P1P * 2 <= 225 * MiB && (size_t)MT * 768 * 2 <= 54 * MiB, "ws map");
constexpr size_t SZ_GU = (size_t)5632 * 1024, SZ_WD = (size_t)1024 * 2816;
constexpr size_t WO_GU = 0, WO_WD = WO_GU + 4 * SZ_GU, WO_WIN0 = WO_WD + 4 * SZ_WD, WO_WQB = WO_WIN0 + (size_t)1280 * 1024, WO_WKVB = WO_WQB + (size_t)768 * 256,
                 WO_WOUT0 = WO_WKVB + (size_t)1024 * 128, WO_WIN1 = WO_WOUT0 + (size_t)1024 * 1024, WO_WOUT1 = WO_WIN1 + (size_t)3072 * 1024, WO_END = WO_WOUT1 + (size_t)1024 * 1024;
static_assert(WO_END * 2 <= 80 * MiB, "weights fit");
constexpr int LDS_BYTES = 131072 + 1024;

__device__ __forceinline__ float bflo(unsigned u) { return __uint_as_float(u << 16); }
__device__ __forceinline__ float bfhi(unsigned u) { return __uint_as_float(u & 0xffff0000u); }
__device__ __forceinline__ float shx(float v, int mask, int lane) { return __int_as_float(__builtin_amdgcn_ds_bpermute((lane ^ mask) << 2, __float_as_int(v))); }
__device__ __forceinline__ float wave_sum(float v, int lane) {
#pragma unroll
    for (int o = 1; o < 64; o <<= 1) v += shx(v, o, lane);
    return v;
}
#define LDS_WAIT() asm volatile("s_waitcnt lgkmcnt(0)" ::: "memory")

__device__ __forceinline__ void conv_item(const float* __restrict__ W, int K, int N, bf16_t* WT, int mode, LAS float* scr, int item, int lane) {
    const int nblk = N / 32, kb = item / nblk, nb = item % nblk, k0 = 64 * kb, n0 = 32 * nb;
#pragma unroll 8
    for (int i = 0; i < 32; ++i) { const int kk = 2 * i + (lane >> 5); scr[kk * 33 + (lane & 31)] = W[(size_t)(k0 + kk) * N + n0 + (lane & 31)]; }
    LDS_WAIT();
    const int drow0 = mode == 0 ? n0 : mode == 3 ? ((n0 & ~255) + 128 * ((n0 >> 5) & 1) + 32 * ((n0 >> 6) & 3))
                                         : ((n0 >> 7) * 256 + (n0 & 127) + (mode == 2 ? 128 : 0));
    const int c = lane & 7;
#pragma unroll
    for (int j = 0; j < 4; ++j) { const int n = (lane >> 3) + 8 * j; const LAS float* s = scr + (8 * c) * 33 + n;
        u32x4 o; o.x = pk_bf16(s[0 * 33], s[1 * 33]); o.y = pk_bf16(s[2 * 33], s[3 * 33]); o.z = pk_bf16(s[4 * 33], s[5 * 33]); o.w = pk_bf16(s[6 * 33], s[7 * 33]);
        *(u32x4*)(WT + (size_t)(drow0 + n) * K + k0 + 8 * c) = o; }
    LDS_WAIT();
}
__device__ __forceinline__ void sincos_d(double a, float& sn, float& cs) {
    const double k = __builtin_rint(a * 0.63661977236758134308); const double r = a - k * 1.57079632679489661923; const double r2 = r * r;
    const double s = r * (1.0 + r2 * (-1.0 / 6 + r2 * (1.0 / 120 + r2 * (-1.0 / 5040 + r2 * (1.0 / 362880 + r2 * (-1.0 / 39916800))))));
    const double c = 1.0 + r2 * (-0.5 + r2 * (1.0 / 24 + r2 * (-1.0 / 720 + r2 * (1.0 / 40320 + r2 * (-1.0 / 3628800 + r2 * (1.0 / 479001600))))));
    const int q = ((int)k) & 3;
    const double so = (q == 0) ? s : (q == 1) ? c : (q == 2) ? -s : -c;
    const double co = (q == 0) ? c : (q == 1) ? -s : (q == 2) ? -c : s;
    sn = (float)so; cs = (float)co;
}

typedef _Float16 f16x4m __attribute__((ext_vector_type(4)));
__device__ __forceinline__ void norm_phase(const void* lat, bool lat16, const void* ctxp, bool ctx16, int nrows, const float* __restrict__ g, const float* __restrict__ modl, int k, bf16_t* A, int gw, int NGW, int lane, const _Float16* part, _Float16* ctx_out) {
    for (int row = gw; row < nrows; row += NGW) {
        const bool isctx = row >= ML; const size_t ro = (size_t)(isctx ? row - ML : row) * D + 4 * lane; const void* src = isctx ? ctxp : lat; const bool s16 = isctx ? ctx16 : lat16;
        const int bidx = isctx ? 16 : (row >> 11);
        const float* sh = modl + (size_t)bidx * 9216 + (3 * k) * 1024; const float* sc = sh + 1024;
        f32x4 v[4]; float ss = 0.f;
        if (s16) {
#pragma unroll
            for (int j = 0; j < 4; ++j) { const f16x4m hv = *(const f16x4m*)((const _Float16*)src + ro + 256 * j); v[j] = (f32x4){(float)hv[0], (float)hv[1], (float)hv[2], (float)hv[3]}; }
        } else {
#pragma unroll
            for (int j = 0; j < 4; ++j) v[j] = *(const f32x4*)((const float*)src + ro + 256 * j);
        }
        if (isctx && part != nullptr) {
#pragma unroll
            for (int j = 0; j < 4; ++j) { const f16x4m q0 = *(const f16x4m*)(part + ro + 256 * j), q1 = *(const f16x4m*)(part + (size_t)4096 * 1024 + ro + 256 * j), q2 = *(const f16x4m*)(part + (size_t)2 * 4096 * 1024 + ro + 256 * j), q3 = *(const f16x4m*)(part + (size_t)3 * 4096 * 1024 + ro + 256 * j);
                const f32x4 p0 = (f32x4){(float)q0[0], (float)q0[1], (float)q0[2], (float)q0[3]}, p1 = (f32x4){(float)q1[0], (float)q1[1], (float)q1[2], (float)q1[3]}, p2 = (f32x4){(float)q2[0], (float)q2[1], (float)q2[2], (float)q2[3]}, p3 = (f32x4){(float)q3[0], (float)q3[1], (float)q3[2], (float)q3[3]};
                v[j] = v[j] + ((p0 + p1) + (p2 + p3)); f16x4m ho; ho[0] = (_Float16)v[j][0]; ho[1] = (_Float16)v[j][1]; ho[2] = (_Float16)v[j][2]; ho[3] = (_Float16)v[j][3]; *(f16x4m*)(ctx_out + ro + 256 * j) = ho; } }
#pragma unroll
        for (int j = 0; j < 4; ++j) ss += (v[j].x * v[j].x + v[j].y * v[j].y) + (v[j].z * v[j].z + v[j].w * v[j].w);
        ss = wave_sum(ss, lane); const float r = 1.0f / sqrtf(ss * (1.0f / 1024.0f) + EPS);
#pragma unroll
        for (int j = 0; j < 4; ++j) { const int c = 4 * lane + 256 * j; const f32x4 gv = *(const f32x4*)(g + c), scv = *(const f32x4*)(sc + c), shv = *(const f32x4*)(sh + c);
            const f32x4 y = v[j] * r * gv * (scv + 1.0f) + shv;
            u32x2 w; w.x = pk_bf16(y.x, y.y); w.y = pk_bf16(y.z, y.w); *(u32x2*)(A + (size_t)row * D + c) = w; }
    }
}

__device__ __forceinline__ void head_nr64(int lane, bf16_t* hp, const u32x2 w1, const u32x2 w2, int sub, const float* __restrict__ g, bool rope, int t, const float* __restrict__ cs, const float* __restrict__ sn, float oscale, bool dostore) {
    float a[4] = {bflo(w1.x), bfhi(w1.x), bflo(w1.y), bfhi(w1.y)}, b[4] = {bflo(w2.x), bfhi(w2.x), bflo(w2.y), bfhi(w2.y)};
    float ss = 0.f;
#pragma unroll
    for (int e = 0; e < 4; ++e) ss += a[e] * a[e] + b[e] * b[e];
    ss += shx(ss, 1, lane); ss += shx(ss, 2, lane); ss += shx(ss, 4, lane);
    const float r = 1.0f / sqrtf(ss * (1.0f / 64.0f) + EPS);
    const f32x4 g1 = *(const f32x4*)(g + 4 * sub), g2 = *(const f32x4*)(g + 32 + 4 * sub);
#pragma unroll
    for (int e = 0; e < 4; ++e) { a[e] *= r * g1[e]; b[e] *= r * g2[e]; }
    if (rope) { const f32x4 c = *(const f32x4*)(cs + t * 32 + 4 * sub), s = *(const f32x4*)(sn + t * 32 + 4 * sub);
#pragma unroll
        for (int e = 0; e < 4; ++e) { const float na = a[e] * c[e] - b[e] * s[e], nb = a[e] * s[e] + b[e] * c[e]; a[e] = na; b[e] = nb; } }
#pragma unroll
    for (int e = 0; e < 4; ++e) { a[e] *= oscale; b[e] *= oscale; }
    if (dostore) { u32x2 o1, o2; o1.x = pk_bf16(a[0], a[1]); o1.y = pk_bf16(a[2], a[3]); o2.x = pk_bf16(b[0], b[1]); o2.y = pk_bf16(b[2], b[3]);
        *(u32x2*)(hp + 4 * sub) = o1; *(u32x2*)(hp + 32 + 4 * sub) = o2; }
}
__device__ __forceinline__ void head_nr96(int lane, const u32x4 wn, const unsigned wa, const unsigned wb, bf16_t* dst, int sub, const float* __restrict__ g, bool rope, int t, const float* __restrict__ cs, const float* __restrict__ sn, float oscale) {
    float n[8] = {bflo(wn.x), bfhi(wn.x), bflo(wn.y), bfhi(wn.y), bflo(wn.z), bfhi(wn.z), bflo(wn.w), bfhi(wn.w)};
    float a[2] = {bflo(wa), bfhi(wa)}, b[2] = {bflo(wb), bfhi(wb)};
    float ss = a[0] * a[0] + a[1] * a[1] + b[0] * b[0] + b[1] * b[1];
#pragma unroll
    for (int e = 0; e < 8; ++e) ss += n[e] * n[e];
    ss += shx(ss, 1, lane); ss += shx(ss, 2, lane); ss += shx(ss, 4, lane);
    const float r = 1.0f / sqrtf(ss * (1.0f / 96.0f) + EPS);
    const f32x4 ga = *(const f32x4*)(g + 8 * sub), gb = *(const f32x4*)(g + 8 * sub + 4);
#pragma unroll
    for (int e = 0; e < 4; ++e) { n[e] *= r * ga[e] * oscale; n[4 + e] *= r * gb[e] * oscale; }
#pragma unroll
    for (int e = 0; e < 2; ++e) { a[e] *= r * g[64 + 2 * sub + e]; b[e] *= r * g[80 + 2 * sub + e]; }
    if (rope) {
#pragma unroll
        for (int e = 0; e < 2; ++e) { const float c = cs[t * 16 + 2 * sub + e], s = sn[t * 16 + 2 * sub + e]; const float na = a[e] * c - b[e] * s, nb = a[e] * s + b[e] * c; a[e] = na; b[e] = nb; } }
    u32x4 o; o.x = pk_bf16(n[0], n[1]); o.y = pk_bf16(n[2], n[3]); o.z = pk_bf16(n[4], n[5]); o.w = pk_bf16(n[6], n[7]);
    *(u32x4*)(dst + 8 * sub) = o;
    *(unsigned*)(dst + 64 + 2 * sub) = pk_bf16(a[0] * oscale, a[1] * oscale); *(unsigned*)(dst + 80 + 2 * sub) = pk_bf16(b[0] * oscale, b[1] * oscale);
}

#define MFMA32(a, b, c) __builtin_amdgcn_mfma_f32_32x32x16_bf16((a), (b), (c), 0, 0, 0)
__device__ __forceinline__ int crow(int reg, int h) { return (reg & 3) + 8 * (reg >> 2) + 4 * h; }
__device__ __forceinline__ s16x4 vtr(const LAS unsigned char* p) { return __builtin_bit_cast(s16x4, __builtin_amdgcn_ds_read_tr16_b64_v4i16((LAS v4i16_t*)p)); }
__device__ __forceinline__ bf16x8 pack_step(const f32x16& x, int s) {
    u32x4 p; p.x = pk_bf16(x[8 * s + 0], x[8 * s + 1]); p.y = pk_bf16(x[8 * s + 2], x[8 * s + 3]); p.z = pk_bf16(x[8 * s + 4], x[8 * s + 5]); p.w = pk_bf16(x[8 * s + 6], x[8 * s + 7]);
    return __builtin_bit_cast(bf16x8, p);
}
template <int DQK, int DV, int KW, bool MASK>
__device__ __forceinline__ void attn_run(LAS unsigned char* lds, int tid, const bf16_t* __restrict__ Kg, int kpitch, const bf16_t* __restrict__ Vg, int vpitch,
                                         int ctx_row0, int lat_row0, int nt, const bf16x8 (&qf)[DQK / 16], int koffB, int qpos, int kpos0, bool late,
                                         f32x16 (&o)[DV / 32], float& m_out, float& l_out) {
    constexpr int KP = KW * 2 + 16, VP = DV * 2 + 64, KB = 64 * KP, VB = 64 * VP;
    constexpr int KCPR = KW / 8, VCPR = DV / 8, NKC = 64 * KCPR, NVC = 64 * VCPR, NKI = (NKC + 511) / 512, NVI = (NVC + 511) / 512;
    static_assert(2 * KB + 3 * VB <= 131072, "attention tiles fit");
    static_assert(NVC % 512 == 0, "V chunks");
    const int lane = tid & 63, r = lane & 31, h = lane >> 5;
    const int q4 = (lane & 15) >> 2, p4 = lane & 3, blk = (lane >> 4) & 1;
    unsigned vlane = (unsigned)((4 * h + q4) * VP + 32 * blk + 8 * p4), klane = (unsigned)(r * KP + koffB + h * 16); asm volatile("" : "+v"(vlane), "+v"(klane));
    unsigned kst[NKI], vst[NVI];
#pragma unroll
    for (int i_ = 0; i_ < NKI; ++i_) { const int c_ = tid + 512 * i_; kst[i_] = (unsigned)((c_ / KCPR) * KP + (c_ % KCPR) * 16); asm volatile("" : "+v"(kst[i_])); }
#pragma unroll
    for (int i_ = 0; i_ < NVI; ++i_) { const int c_ = tid + 512 * i_; vst[i_] = (unsigned)((c_ / VCPR) * VP + (c_ % VCPR) * 16); asm volatile("" : "+v"(vst[i_])); }
    u32x4 kregA[NKI], vregA[NVI];
#define ATT_GLOAD(t, KR, VR) do { const int tr_ = (t) < 4 ? ctx_row0 + 64 * (t) : lat_row0 + 64 * ((t) - 4); \
        _Pragma("unroll") for (int i_ = 0; i_ < NKI; ++i_) { const int c_ = tid + 512 * i_; if ((NKC % 512 == 0) || c_ < NKC) { const int rr_ = c_ / KCPR, cc_ = c_ % KCPR; KR[i_] = *(const u32x4*)(Kg + (size_t)(tr_ + rr_) * kpitch + cc_ * 8); } } \
        _Pragma("unroll") for (int i_ = 0; i_ < NVI; ++i_) { const int c_ = tid + 512 * i_; const int rr_ = c_ / VCPR, cc_ = c_ % VCPR; VR[i_] = *(const u32x4*)(Vg + (size_t)(tr_ + rr_) * vpitch + cc_ * 8); } } while (0)
#define ATT_LSTORE(kslot, vslot, KR, VR) do { LAS unsigned char* kb_ = lds + (kslot) * KB; LAS unsigned char* vb_ = lds + 2 * KB + (vslot) * VB; \
        _Pragma("unroll") for (int i_ = 0; i_ < NKI; ++i_) { const int c_ = tid + 512 * i_; if ((NKC % 512 == 0) || c_ < NKC) { *(LAS u32x4*)(kb_ + kst[i_]) = KR[i_]; } } \
        _Pragma("unroll") for (int i_ = 0; i_ < NVI; ++i_) { *(LAS u32x4*)(vb_ + vst[i_]) = VR[i_]; } } while (0)
#define ATT_SB() __builtin_amdgcn_sched_barrier(0)
#define ATT_BAR() do { asm volatile("s_waitcnt lgkmcnt(0)" ::: "memory"); __builtin_amdgcn_s_barrier(); asm volatile("" ::: "memory"); } while (0)
#define ATT_VLOAD(dst, vb_, c_) do { _Pragma("unroll") for (int e_ = 0; e_ < 2; ++e_) { const int g_ = (c_) / (DV / 64), db_ = 2 * ((c_) % (DV / 64)) + e_; \
            const LAS unsigned char* vp_ = (vb_) + ((32 * (g_ >> 1) + 16 * (g_ & 1)) * VP + 64 * db_); \
            const s16x4 lo_ = vtr(vp_), hi_ = vtr(vp_ + 8 * VP); dst[e_] = __builtin_shufflevector(lo_, hi_, 0, 1, 2, 3, 4, 5, 6, 7); } } while (0)
#define ATT_PVM(src, c_) do { _Pragma("unroll") for (int e_ = 0; e_ < 2; ++e_) { const int g_ = (c_) / (DV / 64), db_ = 2 * ((c_) % (DV / 64)) + e_; o[db_] = MFMA32(src[e_], pw[g_], o[db_]); } } while (0)
#define ATT_PV(vbase) do { const LAS unsigned char* vbp_ = (vbase); bf16x8 va_[2], vc_[2]; constexpr int NC_ = 4 * (DV / 64); \
        ATT_VLOAD(va_, vbp_, 0); ATT_SB(); \
        _Pragma("unroll") for (int c2_ = 0; c2_ < NC_; c2_ += 2) { \
            ATT_VLOAD(vc_, vbp_, c2_ + 1); ATT_SB(); ATT_PVM(va_, c2_); ATT_SB(); \
            if (c2_ + 2 < NC_) { ATT_VLOAD(va_, vbp_, c2_ + 2); } ATT_SB(); ATT_PVM(vc_, c2_ + 1); ATT_SB(); } } while (0)
    ATT_GLOAD(0, kregA, vregA); ATT_LSTORE(0, 0, kregA, vregA);
    ATT_BAR();
    float m = 0.f, l = 0.f; f32x16 negm; { float z_ = 0.f; asm volatile("" : "+v"(z_));
#pragma unroll
    for (int i = 0; i < 16; ++i) negm[i] = z_; }
    bf16x8 pw[4];
#pragma unroll
    for (int i = 0; i < 4; ++i) pw[i] = (bf16x8){0, 0, 0, 0, 0, 0, 0, 0};
    int vcur = 0, vprev = 0;
    for (int t2 = 0; t2 < nt; t2 += 2) {
#pragma unroll
    for (int par = 0; par < 2; ++par) { const int t = t2 + par; if (t < nt) {
        const int vnext = (vcur == 2) ? 0 : vcur + 1;
        if (t + 1 < nt) ATT_GLOAD(t + 1, kregA, vregA);
        const LAS unsigned char* kb = lds + (t & 1) * KB + klane;
        bf16x8 kf[2 * (DQK / 16)];
#pragma unroll
        for (int d0 = 0; d0 < DQK / 16; ++d0) {
            kf[2 * d0] = *(const LAS bf16x8*)(kb + d0 * 32);
            kf[2 * d0 + 1] = *(const LAS bf16x8*)(kb + 32 * KP + d0 * 32);
        }
        ATT_SB();
        if (late && t > 0) ATT_PV(lds + 2 * KB + vprev * VB + vlane);
        f32x16 s0 = negm, s1 = negm;
#pragma unroll
        for (int d0 = 0; d0 < DQK / 16; ++d0) { s0 = MFMA32(kf[2 * d0], qf[d0], s0); s1 = MFMA32(kf[2 * d0 + 1], qf[d0], s1); }
        ATT_SB();
        if (MASK) { if (t >= 4) { const int dq = kpos0 + 64 * (t - 4) - qpos;
#pragma unroll
            for (int i = 0; i < 16; ++i) { const int d0_ = dq + crow(i, h); if (d0_ > 128 || d0_ < -128) s0[i] = -INFINITY; const int d1_ = d0_ + 32; if (d1_ > 128 || d1_ < -128) s1[i] = -INFINITY; } } }
        float mt = __builtin_fmaxf(s0[0], s1[0]), mu = __builtin_fmaxf(s0[1], s1[1]);
#pragma unroll
        for (int i = 2; i < 16; i += 2) { mt = __builtin_fmaxf(__builtin_fmaxf(mt, s0[i]), s1[i]); mu = __builtin_fmaxf(__builtin_fmaxf(mu, s0[i + 1]), s1[i + 1]); }
        mt = __builtin_fmaxf(mt, mu);
        { auto rr = __builtin_amdgcn_permlane32_swap(__float_as_uint(mt), __float_as_uint(mt), false, false); mt = fmaxf(__uint_as_float(rr[0]), __uint_as_float(rr[1])); }
        constexpr float THR = 4.0f;
        if (t == 0 || __builtin_amdgcn_ballot_w64(mt > THR) != 0ull) {
            const float delta = (t == 0) ? mt : __builtin_fmaxf(mt, 0.f);
            if (t != 0) { const float alpha = __builtin_amdgcn_exp2f(-delta); l *= alpha;
#pragma unroll
                for (int db = 0; db < DV / 32; ++db)
#pragma unroll
                    for (int i = 0; i < 16; ++i) o[db][i] *= alpha; }
            m += delta;
#pragma unroll
            for (int i = 0; i < 16; ++i) { s0[i] -= delta; s1[i] -= delta; negm[i] = -m; }
            asm volatile("" : "+v"(negm));
        }
        float ps = 0.f;
#pragma unroll
        for (int i = 0; i < 16; ++i) { s0[i] = __builtin_amdgcn_exp2f(s0[i]); s1[i] = __builtin_amdgcn_exp2f(s1[i]); ps += s0[i] + s1[i]; }
        l += ps;
        pw[0] = pack_step(s0, 0); pw[1] = pack_step(s0, 1); pw[2] = pack_step(s1, 0); pw[3] = pack_step(s1, 1);
        if (!late) ATT_PV(lds + 2 * KB + vcur * VB + vlane);
        if (t + 1 < nt) ATT_LSTORE((t + 1) & 1, vnext, kregA, vregA);
        vprev = vcur; vcur = vnext;
        ATT_BAR();
    } } }
    if (late) ATT_PV(lds + 2 * KB + vprev * VB + vlane);
    ATT_BAR();
    m_out = m; l_out = l;
#undef ATT_GLOAD
#undef ATT_LSTORE
#undef ATT_PV
#undef ATT_PVM
#undef ATT_VLOAD
#undef ATT_SB
#undef ATT_BAR
}

template <int DQK, int DV, int KW, bool MASK>
__device__ __forceinline__ void attn_run2(LAS unsigned char* lds, int tid, const bf16_t* __restrict__ Kg, int kpitch, const bf16_t* __restrict__ Vg, int vpitch,
                                          int ctx_row0, int lat_row0, int nt, const bf16x8 (&qf)[DQK / 16], int koffB, int qpos, int kpos0,
                                          f32x16 (&o)[DV / 32], float& m_out, float& l_out) {
    constexpr int KP = KW * 2 + 16, VP = DV * 2 + 64, KB = 64 * KP, VB = 64 * VP, ND = DQK / 16;
    constexpr int KCPR = KW / 8, VCPR = DV / 8, NKC = 64 * KCPR, NVC = 64 * VCPR, NKI = (NKC + 511) / 512, NVI = (NVC + 511) / 512;
    static_assert(2 * KB + 3 * VB <= 131072 && NVC % 512 == 0 && ND % 2 == 0, "attention tiles");
    const int lane = tid & 63, r = lane & 31, h = lane >> 5;
    const int q4 = (lane & 15) >> 2, p4 = lane & 3, blk = (lane >> 4) & 1;
    u32x4 kregA[NKI], vregA[NVI], kregB[NKI], vregB[NVI];
#define A2_GLOAD(t, KR, VR) do { const int tr_ = (t) < 4 ? ctx_row0 + 64 * (t) : lat_row0 + 64 * ((t) - 4); \
        _Pragma("unroll") for (int i_ = 0; i_ < NKI; ++i_) { const int c_ = tid + 512 * i_; if ((NKC % 512 == 0) || c_ < NKC) { const int rr_ = c_ / KCPR, cc_ = c_ % KCPR; KR[i_] = *(const u32x4*)(Kg + (size_t)(tr_ + rr_) * kpitch + cc_ * 8); } } \
        _Pragma("unroll") for (int i_ = 0; i_ < NVI; ++i_) { const int c_ = tid + 512 * i_; const int rr_ = c_ / VCPR, cc_ = c_ % VCPR; VR[i_] = *(const u32x4*)(Vg + (size_t)(tr_ + rr_) * vpitch + cc_ * 8); } } while (0)
#define A2_LSTORE(kslot, vslot, KR, VR) do { LAS unsigned char* kb_ = lds + (kslot) * KB; LAS unsigned char* vb_ = lds + 2 * KB + (vslot) * VB; \
        _Pragma("unroll") for (int i_ = 0; i_ < NKI; ++i_) { const int c_ = tid + 512 * i_; if ((NKC % 512 == 0) || c_ < NKC) { const int rr_ = c_ / KCPR, cc_ = c_ % KCPR; *(LAS u32x4*)(kb_ + rr_ * KP + cc_ * 16) = KR[i_]; } } \
        _Pragma("unroll") for (int i_ = 0; i_ < NVI; ++i_) { const int c_ = tid + 512 * i_; const int rr_ = c_ / VCPR, cc_ = c_ % VCPR; *(LAS u32x4*)(vb_ + rr_ * VP + cc_ * 16) = VR[i_]; } } while (0)
#define A2_SB() __builtin_amdgcn_sched_barrier(0)
#define A2_KFRAG(kb_, d0_, half_) (*(const LAS bf16x8*)((kb_) + ((half_) * 32 + r) * KP + koffB + (d0_) * 32 + h * 16))
#define A2_EL(P0, P1, e_) (((e_) < 16) ? P0[(e_) & 15] : P1[(e_) & 15])
#define A2_FILLA(P0, P1, j_) do { if ((j_) < 8) { const int e_ = 4 * (j_); \
        sacc += (A2_EL(P0, P1, e_) + A2_EL(P0, P1, e_ + 1)) + (A2_EL(P0, P1, e_ + 2) + A2_EL(P0, P1, e_ + 3)); \
        pw[((j_) >> 2) * 2 + (((j_) & 3) >> 1)][2 * ((j_) & 1)] = pk_bf16(A2_EL(P0, P1, e_), A2_EL(P0, P1, e_ + 1)); \
        pw[((j_) >> 2) * 2 + (((j_) & 3) >> 1)][2 * ((j_) & 1) + 1] = pk_bf16(A2_EL(P0, P1, e_ + 2), A2_EL(P0, P1, e_ + 3)); } } while (0)
#define A2_QK(S0, S1, kb_, FILL, P0, P1) do { bf16x8 ka_[2], kc_[2]; \
        ka_[0] = A2_KFRAG(kb_, 0, 0); ka_[1] = A2_KFRAG(kb_, 0, 1); A2_SB(); \
        _Pragma("unroll") for (int d_ = 0; d_ < ND; d_ += 2) { \
            kc_[0] = A2_KFRAG(kb_, d_ + 1, 0); kc_[1] = A2_KFRAG(kb_, d_ + 1, 1); A2_SB(); \
            S0 = MFMA32(ka_[0], qf[d_], S0); if (FILL) A2_FILLA(P0, P1, 2 * d_); A2_SB(); \
            S1 = MFMA32(ka_[1], qf[d_], S1); if (FILL) A2_FILLA(P0, P1, 2 * d_ + 1); A2_SB(); \
            if (d_ + 2 < ND) { ka_[0] = A2_KFRAG(kb_, d_ + 2, 0); ka_[1] = A2_KFRAG(kb_, d_ + 2, 1); } A2_SB(); \
            S0 = MFMA32(kc_[0], qf[d_ + 1], S0); if (FILL) A2_FILLA(P0, P1, 2 * d_ + 2); A2_SB(); \
            S1 = MFMA32(kc_[1], qf[d_ + 1], S1); if (FILL) A2_FILLA(P0, P1, 2 * d_ + 3); A2_SB(); } } while (0)
#define A2_VLOAD(dst, vb_, c_) do { _Pragma("unroll") for (int e_ = 0; e_ < 2; ++e_) { const int g_ = (c_) / (DV / 64), db_ = 2 * ((c_) % (DV / 64)) + e_; \
            const LAS unsigned char* vp_ = (vb_) + (32 * (g_ >> 1) + 16 * (g_ & 1) + 4 * h + q4) * VP + (32 * db_ + 16 * blk) * 2 + 8 * p4; \
            const s16x4 lo_ = vtr(vp_), hi_ = vtr(vp_ + 8 * VP); dst[e_] = __builtin_shufflevector(lo_, hi_, 0, 1, 2, 3, 4, 5, 6, 7); } } while (0)
#define A2_FILLB(S0, S1, gap_) do { constexpr int EPG_ = 32 / (8 * (DV / 64)); _Pragma("unroll") for (int i_ = 0; i_ < EPG_; ++i_) { const int e_ = (gap_) * EPG_ + i_; \
        if (e_ < 16) S0[e_ & 15] = __builtin_amdgcn_exp2f(S0[e_ & 15] - m); else S1[e_ & 15] = __builtin_amdgcn_exp2f(S1[e_ & 15] - m); } } while (0)
#define A2_PVM1(src, c_, e_) do { const int g_ = (c_) / (DV / 64), db_ = 2 * ((c_) % (DV / 64)) + (e_); o[db_] = MFMA32(src[e_], __builtin_bit_cast(bf16x8, pw[g_]), o[db_]); } while (0)
#define A2_PV(vbase, S0, S1, DOEXP) do { const LAS unsigned char* vbp_ = (vbase); bf16x8 va_[2], vc_[2]; constexpr int NC_ = 4 * (DV / 64); \
        A2_VLOAD(va_, vbp_, 0); A2_SB(); \
        _Pragma("unroll") for (int c2_ = 0; c2_ < NC_; c2_ += 2) { \
            A2_VLOAD(vc_, vbp_, c2_ + 1); A2_SB(); \
            A2_PVM1(va_, c2_, 0); if (DOEXP) A2_FILLB(S0, S1, 2 * c2_); A2_SB(); \
            A2_PVM1(va_, c2_, 1); if (DOEXP) A2_FILLB(S0, S1, 2 * c2_ + 1); A2_SB(); \
            if (c2_ + 2 < NC_) { A2_VLOAD(va_, vbp_, c2_ + 2); } A2_SB(); \
            A2_PVM1(vc_, c2_ + 1, 0); if (DOEXP) A2_FILLB(S0, S1, 2 * c2_ + 2); A2_SB(); \
            A2_PVM1(vc_, c2_ + 1, 1); if (DOEXP) A2_FILLB(S0, S1, 2 * c2_ + 3); A2_SB(); } } while (0)
#define A2_ZERO(S0, S1) do { _Pragma("unroll") for (int i_ = 0; i_ < 16; ++i_) { S0[i_] = 0.f; S1[i_] = 0.f; } } while (0)
#define A2_MASK(S0, S1, t_) do { if (MASK) { if ((t_) >= 4) { const int dq_ = kpos0 + 64 * ((t_) - 4) - qpos; \
        _Pragma("unroll") for (int i_ = 0; i_ < 16; ++i_) { const int d0_ = dq_ + crow(i_, h); if (d0_ > 128 || d0_ < -128) S0[i_] = -INFINITY; const int d1_ = d0_ + 32; if (d1_ > 128 || d1_ < -128) S1[i_] = -INFINITY; } } } } while (0)
#define A2_ROWMAX(S0, S1, mt_) do { mt_ = fmaxf(S0[0], S1[0]); _Pragma("unroll") for (int i_ = 1; i_ < 16; ++i_) mt_ = fmaxf(mt_, fmaxf(S0[i_], S1[i_])); \
        auto rr_ = __builtin_amdgcn_permlane32_swap(__float_as_uint(mt_), __float_as_uint(mt_), false, false); mt_ = fmaxf(__uint_as_float(rr_[0]), __uint_as_float(rr_[1])); } while (0)
#define A2_BAR() do { asm volatile("s_waitcnt lgkmcnt(0)" ::: "memory"); __builtin_amdgcn_s_barrier(); asm volatile("" ::: "memory"); } while (0)
#define A2_STEP(t_, S0, S1, P0, P1, KRL, VRL, KRS, VRS) do { \
        const int vnext_ = (vcur == 2) ? 0 : vcur + 1; \
        if ((t_) + 2 < nt) A2_GLOAD((t_) + 2, KRL, VRL); \
        const LAS unsigned char* kbs_ = lds + ((t_) & 1) * KB; \
        float sacc = 0.f; A2_ZERO(S0, S1); \
        A2_QK(S0, S1, kbs_, true, P0, P1); \
        l += sacc; \
        A2_MASK(S0, S1, t_); \
        float mt_; A2_ROWMAX(S0, S1, mt_); \
        const float mn_ = fmaxf(m, mt_); const bool resc_ = __builtin_amdgcn_ballot_w64(mn_ > m) != 0ull; float alpha_ = 1.0f; \
        if (resc_) { alpha_ = __builtin_amdgcn_exp2f(m - mn_); l *= alpha_; m = mn_; } \
        A2_PV(lds + 2 * KB + vprev * VB, S0, S1, true); \
        if (resc_) { _Pragma("unroll") for (int db_ = 0; db_ < DV / 32; ++db_) _Pragma("unroll") for (int i_ = 0; i_ < 16; ++i_) o[db_][i_] *= alpha_; } \
        if ((t_) + 1 < nt) A2_LSTORE(((t_) + 1) & 1, vnext_, KRS, VRS); \
        vprev = vcur; vcur = vnext_; \
        A2_BAR(); } while (0)
    f32x16 sA0, sA1, sB0, sB1; u32x4 pw[4]; float m, l = 0.f;
    int vcur = 0, vprev = 0;
    A2_GLOAD(0, kregA, vregA); A2_LSTORE(0, 0, kregA, vregA);
    if (1 < nt) A2_GLOAD(1, kregB, vregB);
    A2_BAR();
    {
        if (2 < nt) A2_GLOAD(2, kregA, vregA);
        A2_ZERO(sA0, sA1); float sacc = 0.f;
        A2_QK(sA0, sA1, lds, false, sA0, sA1); (void)sacc;
        A2_MASK(sA0, sA1, 0);
        float mt_; A2_ROWMAX(sA0, sA1, mt_); m = mt_;
#pragma unroll
        for (int i = 0; i < 16; ++i) { sA0[i] = __builtin_amdgcn_exp2f(sA0[i] - m); sA1[i] = __builtin_amdgcn_exp2f(sA1[i] - m); }
        if (1 < nt) A2_LSTORE(1, 1, kregB, vregB);
        vprev = 0; vcur = 1;
        A2_BAR();
    }
    for (int t2 = 1; t2 < nt; t2 += 2) {
        A2_STEP(t2, sB0, sB1, sA0, sA1, kregB, vregB, kregA, vregA);
        if (t2 + 1 < nt) A2_STEP(t2 + 1, sA0, sA1, sB0, sB1, kregA, vregA, kregB, vregB);
    }
    {
        float sacc = 0.f;
        if ((nt - 1) & 1) {
#pragma unroll
            for (int j = 0; j < 8; ++j) A2_FILLA(sB0, sB1, j);
        } else {
#pragma unroll
            for (int j = 0; j < 8; ++j) A2_FILLA(sA0, sA1, j);
        }
        l += sacc;
        A2_PV(lds + 2 * KB + vprev * VB, sA0, sA1, false);
    }
    __syncthreads();
    m_out = m; l_out = l;
#undef A2_GLOAD
#undef A2_LSTORE
#undef A2_SB
#undef A2_KFRAG
#undef A2_EL
#undef A2_FILLA
#undef A2_QK
#undef A2_VLOAD
#undef A2_FILLB
#undef A2_PVM1
#undef A2_PV
#undef A2_ZERO
#undef A2_MASK
#undef A2_ROWMAX
#undef A2_STEP
#undef A2_BAR
}
template <int NDB>
__device__ __forceinline__ void write_o(int lane, const f32x16 (&o)[NDB], float l, float m, bool sink, float sinkv, bf16_t* obase, int hh, LAS unsigned char* stg) {
    float lt = l + shx(l, 32, lane); if (sink) lt += __builtin_amdgcn_exp2f(sinkv - m);
    const float inv = 1.0f / lt;
    constexpr int RB = NDB * 64 + 16, CPR = NDB * 4;
    LAS unsigned char* wp = stg + (lane & 31) * RB + 8 * hh;
#pragma unroll
    for (int db = 0; db < NDB; ++db)
#pragma unroll
        for (int g = 0; g < 4; ++g) { u32x2 w; w.x = pk_bf16(o[db][4 * g] * inv, o[db][4 * g + 1] * inv); w.y = pk_bf16(o[db][4 * g + 2] * inv, o[db][4 * g + 3] * inv);
            *(LAS u32x2*)(wp + 64 * db + 16 * g) = w; }
    asm volatile("s_waitcnt lgkmcnt(0)" ::: "memory");
#pragma unroll
    for (int i = 0; i < 32 * CPR / 64; ++i) { const int c = i * 64 + lane, row = c / CPR, ch = c % CPR;
        const u32x4 v = *(const LAS u32x4*)(stg + row * RB + ch * 16); *(u32x4*)(obase + (size_t)row * 1024 + ch * 8) = v; }
    asm volatile("s_waitcnt lgkmcnt(0)" ::: "memory");
}

#define XB_TMO      128
#define XB_XCNT(j)  (256  + 64 * (j))
#define XB_XSUB(j)  (1280 + 64 * (j))
#define XB_XGEN(j)  (2304 + 64 * (j))
#define XB_TOP      3328
#define XB_TOPGEN   3392
#define XCD_BAR_WORDS 3456
#define XB_SPIN_CAP (1u << 18)
__device__ __forceinline__ unsigned xb_ld(unsigned* p)              { return __hip_atomic_load(p, __ATOMIC_RELAXED, __HIP_MEMORY_SCOPE_AGENT); }
__device__ __forceinline__ unsigned xb_add(unsigned* p, unsigned v) { return __hip_atomic_fetch_add(p, v, __ATOMIC_RELAXED, __HIP_MEMORY_SCOPE_AGENT); }
__device__ __forceinline__ unsigned xb_xcc_id() { return (unsigned)__builtin_amdgcn_s_getreg((3 << 11) | 20) & 0xFu; }
#define XB_SPIN(cond, bar) do { unsigned _sp = 0; while (cond) { __builtin_amdgcn_s_sleep(1); \
    if ((++_sp & 255u) == 0u) { if (xb_ld(&(bar)[XB_TMO])) break; if (_sp > XB_SPIN_CAP) { atomicAdd(&(bar)[XB_TMO], 1u); break; } } } } while (0)
__device__ __forceinline__ void xcd_barrier_complete(unsigned* bar, unsigned x, unsigned& nloc, unsigned& nx) {
    const unsigned G = gridDim.x * gridDim.y * gridDim.z;
    unsigned sum, cnt, mine, sp = 0u;
    for (;;) {
        sum = 0u; cnt = 0u; mine = 0u;
#pragma unroll
        for (unsigned j = 0; j < 16; ++j) { const unsigned c = xb_ld(&bar[XB_XCNT(j)]); sum += c; cnt += (c > 0u) ? 1u : 0u; mine = (j == x) ? c : mine; }
        if (sum == G) break;
        __builtin_amdgcn_s_sleep(1);
        if ((++sp & 255u) == 0u) { if (xb_ld(&bar[XB_TMO])) break; if (sp > XB_SPIN_CAP) { atomicAdd(&bar[XB_TMO], 1u); break; } }
    }
    nloc = mine > 0u ? mine : 1u; nx = cnt > 0u ? cnt : 1u;
}
__device__ __forceinline__ void xcd_barrier(unsigned* bar, volatile LAS unsigned* st, int tid) {
    asm volatile("s_waitcnt vmcnt(0)" ::: "memory");
    __syncthreads();
    if (tid == 0) {
        const unsigned x = xb_xcc_id();
        __builtin_amdgcn_s_waitcnt(0);
        unsigned nloc = st[0], nx = st[1];
        if (nloc == 0u) { xcd_barrier_complete(bar, x, nloc, nx); st[0] = nloc; st[1] = nx; }
        const unsigned old = xb_add(&bar[XB_XSUB(x)], 1u);
        const unsigned gen = old / nloc;
        if (old + 1u == (gen + 1u) * nloc) {
            __builtin_amdgcn_fence(__ATOMIC_RELEASE, "agent");
            asm volatile("s_waitcnt vmcnt(0)" ::: "memory");
            const unsigned og = xb_add(&bar[XB_TOP], 1u);
            const unsigned tg = og / nx;
            if (og + 1u == (tg + 1u) * nx) xb_add(&bar[XB_TOPGEN], 1u);
            else XB_SPIN(xb_ld(&bar[XB_TOPGEN]) == tg, bar);
            __builtin_amdgcn_fence(__ATOMIC_ACQUIRE, "agent");
            xb_add(&bar[XB_XGEN(x)], 1u);
            asm volatile("s_waitcnt vmcnt(0)" ::: "memory");
        } else {
            XB_SPIN(xb_ld(&bar[XB_XGEN(x)]) == gen, bar);
            __builtin_amdgcn_fence(__ATOMIC_ACQUIRE, "agent");
            asm volatile("s_waitcnt vmcnt(0)" ::: "memory");
        }
    }
    __syncthreads();
}

struct Args { const float* in[36]; float* out; unsigned char* ws; };

__global__ void __launch_bounds__(512) fwd_megakernel(Args a) {
    extern __shared__ __attribute__((aligned(16))) unsigned char lds_raw[];
    LAS unsigned char* lds = (LAS unsigned char*)lds_raw;
    const int wave0 = __builtin_amdgcn_readfirstlane((int)threadIdx.x >> 6);
    typedef const __attribute__((address_space(4))) unsigned char* kptr_t;
    const int G = gridDim.x, bid = blockIdx.x, NGW = G * 8;
#define PHASE_IDS() int tid; asm volatile("v_mbcnt_lo_u32_b32 %0, -1, 0\n\tv_mbcnt_hi_u32_b32 %0, -1, %0" : "=v"(tid)); tid += wave0 * 64; const int lane = tid & 63; const int wave = __builtin_amdgcn_readfirstlane(tid >> 6); const int gw = bid * 8 + wave; (void)lane; (void)wave; (void)gw; \
    kptr_t ka_ = (kptr_t)__builtin_amdgcn_kernarg_segment_ptr(); asm volatile("" : "+s"(ka_)); \
    unsigned char* ws = *(unsigned char* const __attribute__((address_space(4)))*)(ka_ + 37 * 8); float* OUT = *(float* const __attribute__((address_space(4)))*)(ka_ + 36 * 8); \
    float* modtab = (float*)(ws + WS_MOD); float* cos64 = (float*)(ws + WS_ROPE); float* sin64 = cos64 + 2048 * 32; float* cos32 = sin64 + 2048 * 32; float* sin32 = cos32 + 2048 * 16; \
    float* HC = (float*)(ws + WS_HC); bf16_t* W = (bf16_t*)(ws + WS_W); bf16_t* A = (bf16_t*)OUT; _Float16* HL = (_Float16*)(ws + WS_HL); _Float16* HCh = (_Float16*)(ws + WS_HCH); (void)HL; (void)HCh; bf16_t* U = (bf16_t*)(ws + WS_P); bf16_t* P1 = U; bf16_t* P0 = U; \
    bf16_t* Qf = (bf16_t*)(ws + WS_QF); bf16_t* KVf = (bf16_t*)(ws + WS_KVF); bf16_t* MK = (bf16_t*)(ws + WS_MK); \
    const float* modl = modtab + (size_t)l * 17 * 9216; const float* ng = l ? IN(23) : IN(6); \
    (void)modtab; (void)cos64; (void)sin64; (void)cos32; (void)sin32; (void)HC; (void)W; (void)A; (void)U; (void)P1; (void)P0; (void)Qf; (void)KVf; (void)MK; (void)OUT; (void)modl; (void)ng
#define IN(i) (*(const float* const __attribute__((address_space(4)))*)(ka_ + 8 * (i)))
#define PHASE_IDS0() const int l = 0; PHASE_IDS()
#define GRID_BAR() do { int tb_; asm volatile("v_mbcnt_lo_u32_b32 %0, -1, 0\n\tv_mbcnt_hi_u32_b32 %0, -1, %0" : "=v"(tb_)); tb_ += wave0 * 64; \
    kptr_t kb_ = (kptr_t)__builtin_amdgcn_kernarg_segment_ptr(); asm volatile("" : "+s"(kb_)); unsigned char* wsb_ = *(unsigned char* const __attribute__((address_space(4)))*)(kb_ + 37 * 8); \
    xcd_barrier((unsigned*)(wsb_ + WS_BAR), (volatile LAS unsigned*)(lds + 131072 + 512), tb_); } while (0)

    {
        const int l = 0; PHASE_IDS();
        if (tid < 2) ((volatile LAS unsigned*)(lds + 131072 + 512))[tid] = 0u;
        if (bid == 0) { unsigned* bar = (unsigned*)(ws + WS_BAR); for (int i = tid; i < XCD_BAR_WORDS; i += 512) __hip_atomic_store(&bar[i], 0u, __ATOMIC_RELAXED, __HIP_MEMORY_SCOPE_AGENT); }
        for (int i = bid * 512 + tid; i < 2048 * 32 + 2048 * 16; i += G * 512) {
            if (i < 2048 * 32) { const int t = i >> 5, f = i & 31; const float inv = exp2f(-(float)(f & 15) * (13.287712379549449f / 16.0f)); const float pos = (f < 16) ? (float)(t >> 6) : (float)(t & 63);
                const float ang = pos * inv; float sn, cs; sincos_d((double)ang, sn, cs); cos64[i] = cs; sin64[i] = sn; }
            else { const int j = i - 2048 * 32; const int t = j >> 4, f = j & 15; const float inv = exp2f(-(float)(f & 7) * (13.287712379549449f / 8.0f)); const float pos = (f < 8) ? (float)(t >> 6) : (float)(t & 63);
                const float ang = pos * inv; float sn, cs; sincos_d((double)ang, sn, cs); cos32[j] = cs; sin32[j] = sn; }
        }
        for (int i = bid * 512 + tid; i < 96 * 1024 / 8; i += G * 512) *(u32x4*)(W + WO_WIN0 + (size_t)1184 * 1024 + (size_t)i * 8) = (u32x4){0u, 0u, 0u, 0u};
        if (bid < 288) {
            LAS float* sc = (LAS float*)lds;
            LAS float* part = sc + 17 * 1024;
            for (int i = tid; i < 17 * 1024; i += 512) { const float v = i < 16 * 1024 ? IN(1)[i] : IN(3)[i - 16 * 1024]; sc[i] = v / (1.0f + expf(-v)); }
            __syncthreads();
            for (int task = bid; task < 288; task += G) {
                const int l = task / 144, gq = task % 144, j = gq * 64 + lane;
                const float* aw = l ? IN(21) : IN(4); const float* ab = l ? IN(22) : IN(5);
                float acc[17];
#pragma unroll
                for (int b = 0; b < 17; ++b) acc[b] = 0.f;
                const int kbeg = wave * 128;
#pragma unroll 4
                for (int k = kbeg; k < kbeg + 128; ++k) { const float w = aw[(size_t)k * 9216 + j];
#pragma unroll
                    for (int b = 0; b < 17; ++b) acc[b] += sc[b * 1024 + k] * w; }
#pragma unroll
                for (int b = 0; b < 17; ++b) part[(wave * 17 + b) * 64 + lane] = acc[b];
                __syncthreads();
                for (int o = tid; o < 17 * 64; o += 512) { const int b = o >> 6, ln = o & 63; float s = 0.f;
#pragma unroll
                    for (int w = 0; w < 8; ++w) s += part[(w * 17 + b) * 64 + ln];
                    modtab[(size_t)(l * 17 + b) * 9216 + gq * 64 + ln] = s + ab[gq * 64 + ln]; }
                __syncthreads();
            }
        }
        __syncthreads();
        LAS float* scr = (LAS float*)(lds + wave * 16384);
        constexpr int IT_G = 16 * 88, IT_D = 44 * 32, IT_WIN0 = 16 * 37, IT_WQB = 4 * 24, IT_WKVB = 2 * 32, IT_WOUT = 16 * 32, IT_WIN1 = 16 * 96;
        constexpr int NITEMS = 8 * IT_G + 4 * IT_D + IT_WIN0 + IT_WQB + IT_WKVB + 2 * IT_WOUT + IT_WIN1;
        for (int it = gw; it < NITEMS; it += NGW) {
            int r = it;
            if (r < 8 * IT_G) { const int mi = r / IT_G; r -= mi * IT_G; const int l = mi >> 2, s = (mi >> 1) & 1, gu = mi & 1;
                const float* src = (l ? (gu ? IN(25) : IN(24)) : (gu ? IN(8) : IN(7))) + (size_t)s * 1024 * 2816;
                conv_item(src, 1024, 2816, W + WO_GU + (size_t)(l * 2 + s) * SZ_GU, 1 + gu, scr, r, lane); continue; }
            r -= 8 * IT_G;
            if (r < 4 * IT_D) { const int mi = r / IT_D; r -= mi * IT_D; const int l = mi >> 1, s = mi & 1;
                const float* src = (l ? IN(26) : IN(9)) + (size_t)s * 2816 * 1024;
                conv_item(src, 2816, 1024, W + WO_WD + (size_t)(l * 2 + s) * SZ_WD, 0, scr, r, lane); continue; }
            r -= 4 * IT_D;
            if (r < IT_WIN0) { conv_item(IN(10), 1024, 1184, W + WO_WIN0, 0, scr, r, lane); continue; } r -= IT_WIN0;
            if (r < IT_WQB) { conv_item(IN(12), 256, 768, W + WO_WQB, 0, scr, r, lane); continue; } r -= IT_WQB;
            if (r < IT_WKVB) { conv_item(IN(14), 128, 1024, W + WO_WKVB, 0, scr, r, lane); continue; } r -= IT_WKVB;
            if (r < IT_WOUT) { conv_item(IN(20), 1024, 1024, W + WO_WOUT0, 0, scr, r, lane); continue; } r -= IT_WOUT;
            if (r < IT_WIN1) { conv_item(IN(27), 1024, 3072, W + WO_WIN1, 3, scr, r, lane); continue; } r -= IT_WIN1;
            conv_item(IN(35), 1024, 1024, W + WO_WOUT1, 0, scr, r, lane);
        }
    }
    cg::this_grid().sync();
    { PHASE_IDS0(); if (tid == 0) (void)xb_add((unsigned*)(ws + WS_BAR) + XB_XCNT(xb_xcc_id()), 1u); }

#pragma nounroll
    for (int step = 0; step < 4; ++step) {
        const int l = step >> 1, s = step & 1;

        if (s == 1) {
            { PHASE_IDS(); norm_phase(HL, true, l ? (const void*)HCh : (const void*)IN(2), l != 0, MT, ng + 1024, modl, 1, A, gw, NGW, lane, (const _Float16*)(ws + WS_PART), HCh); }
            GRID_BAR();
            if (l == 0) {   PHASE_IDS();
                pg8::Gemm g{A, W + WO_WIN0, MT, P0W, 1024, 1024}; pg8::StaticOrder S; S.init(MT, P0W, G, bid);
                pg8::EpiStoreBf16 E{P0, P0P};
                pg8::gemm_phase<pg8::EpiStoreBf16, pg8::StaticOrder, true, true>(lds, g, S, E, tid);
            } else {        PHASE_IDS();
                pg8::Gemm g{A, W + WO_WIN1, MT, P1W, 1024, 1024}; pg8::StaticOrder S; S.init(MT, P1W, G, bid);
                pg8::EpiQKV1 E{P1, P1P, IN(28), IN(29), cos64, sin64, ML / 256, 0.125f * LOG2E, EPS};
                pg8::gemm_phase<pg8::EpiQKV1, pg8::StaticOrder, true, true>(lds, g, S, E, tid);
            }
            GRID_BAR();
            if (l == 0) {
                { PHASE_IDS();
                for (int row = gw; row < MT; row += NGW) {
                    bf16_t* p = P0 + (size_t)row * P0P; const bool lat = row < ML; const int t = row & 2047; const int sub = lane & 7;
                    bf16_t* hq = p + 416 + (lane >> 3) * 64; bf16_t* hk = p + 928 + ((lane >> 3) & 1) * 64;
                    const u32x2 w = *(const u32x2*)(p + 4 * lane); const unsigned wv = *(const unsigned*)(p + 256 + 2 * lane);
                    const u32x2 q1 = *(const u32x2*)(hq + 4 * sub), q2 = *(const u32x2*)(hq + 32 + 4 * sub), k1 = *(const u32x2*)(hk + 4 * sub), k2 = *(const u32x2*)(hk + 32 + 4 * sub);
                    { const float x0 = bflo(w.x), x1 = bfhi(w.x), x2 = bflo(w.y), x3 = bfhi(w.y);
                      const float ss = wave_sum((x0 * x0 + x1 * x1) + (x2 * x2 + x3 * x3), lane); const float r = 1.0f / sqrtf(ss * (1.0f / 256.0f) + EPS); const f32x4 gq = *(const f32x4*)(IN(11) + 4 * lane);
                      u32x2 o; o.x = pk_bf16(x0 * r * gq.x, x1 * r * gq.y); o.y = pk_bf16(x2 * r * gq.z, x3 * r * gq.w); *(u32x2*)(p + 4 * lane) = o; }
                    { const float x0 = bflo(wv), x1 = bfhi(wv);
                      const float ss = wave_sum(x0 * x0 + x1 * x1, lane); const float r = 1.0f / sqrtf(ss * (1.0f / 128.0f) + EPS);
                      *(unsigned*)(p + 256 + 2 * lane) = pk_bf16(x0 * r * IN(13)[2 * lane], x1 * r * IN(13)[2 * lane + 1]); }
                    head_nr64(lane, hq, q1, q2, sub, IN(17), lat, t, cos64, sin64, 0.125f * LOG2E, true);
                    head_nr64(lane, hk, k1, k2, sub, IN(18), lat, t, cos64, sin64, 1.0f, lane < 16);
                } }
                GRID_BAR();
                {   PHASE_IDS(); pg8::Gemm g{P0, W + WO_WQB, MT, 768, 256, P0P}; pg8::StaticOrder S; S.init(MT, 768, G, bid);
                    pg8::EpiStoreBf16 E{Qf, 768};
                    pg8::gemm_phase<pg8::EpiStoreBf16, pg8::StaticOrder, true, true>(lds, g, S, E, tid); }
                {   PHASE_IDS(); pg8::Gemm g{P0 + 256, W + WO_WKVB, MT, 1024, 128, P0P}; pg8::StaticOrder S; S.init(MT, 1024, G, bid);
                    pg8::EpiStoreBf16 E{KVf, KVP};
                    pg8::gemm_phase<pg8::EpiStoreBf16, pg8::StaticOrder, true, true>(lds, g, S, E, tid); }
                GRID_BAR();
                { PHASE_IDS();
                for (int row = gw; row < MT; row += NGW) {
                    const bool lat = row < ML; const int t = row & 2047; const int hd = lane >> 3, sub = lane & 7;
                    bf16_t* qp = Qf + (size_t)row * 768 + hd * 96; const bf16_t* kvp = KVf + (size_t)row * KVP + hd * 128; const bf16_t* krp = P0 + (size_t)row * P0P + 384;
                    const u32x4 wnq = *(const u32x4*)(qp + 8 * sub); const unsigned waq = *(const unsigned*)(qp + 64 + 2 * sub), wbq = *(const unsigned*)(qp + 80 + 2 * sub);
                    const u32x4 wnk = *(const u32x4*)(kvp + 8 * sub); const unsigned wak = *(const unsigned*)(krp + 2 * sub), wbk = *(const unsigned*)(krp + 16 + 2 * sub);
                    head_nr96(lane, wnq, waq, wbq, qp, sub, IN(15), lat, t, cos32, sin32, 0.10206207261596575f * LOG2E);
                    head_nr96(lane, wnk, wak, wbk, MK + (size_t)row * MKP + hd * 96, sub, IN(16), lat, t, cos32, sin32, 1.0f);
                } }
                GRID_BAR();
                { PHASE_IDS();
                for (int rep_ = 0; rep_ < REP_ATT0; ++rep_)
                for (int u = ((G & 7) == 0 ? (bid & 7) * (G >> 3) + (bid >> 3) : bid); u < 1024 + 128 + 1152; u += G) {

                    const int r = lane & 31, hh = lane >> 5;
                    if (u < 1024 + 128) {
                        int b, h, qrow0, nt;
                        if (u < 1024) { b = u >> 6; h = (u >> 3) & 7; qrow0 = b * 2048 + 256 * (u & 7); nt = 36; }
                        else { const int v = u - 1024; b = v >> 3; h = v & 7; qrow0 = ML + b * 256; nt = 4; }
                        const int qrow = qrow0 + 32 * wave + r;
                        bf16x8 qf[6];
#pragma unroll
                        for (int d0 = 0; d0 < 6; ++d0) qf[d0] = *(const bf16x8*)(Qf + (size_t)qrow * 768 + h * 96 + 16 * d0 + 8 * hh);
                        f32x16 o[2];
#pragma unroll
                        for (int i = 0; i < 16; ++i) { o[0][i] = 0.f; o[1][i] = 0.f; }
                        float m, lsum;
                        attn_run<96, 64, 96, false>(lds, tid, MK + h * 96, MKP, KVf + h * 128 + 64, KVP, ML + b * 256, b * 2048, nt, qf, 0, 0, 0, false, o, m, lsum);
                        write_o<2>(lane, o, lsum, m, false, 0.f, A + (size_t)(qrow - r) * 1024 + h * 64, hh, lds + 65536 + wave * 4608);
                    } else {
                        const int v = u - 1152; const int b = v / 72, kvh = (v / 36) & 1, qb = v % 36;
                        const bool isctx = qb < 4; const int q0l = isctx ? 0 : 64 * (qb - 4);
                        const int hq = kvh * 4 + (wave >> 1), qloc = 32 * (wave & 1) + r;
                        const int qrow = (isctx ? ML + b * 256 + 64 * qb : b * 2048 + q0l) + qloc;
                        int lat0 = 0, nt = 4;
                        if (!isctx) { lat0 = q0l - 128 > 0 ? q0l - 128 : 0; const int last = q0l + 192 < 2048 ? q0l + 192 : 2048; nt = 4 + (last - lat0) / 64; }
                        bf16x8 qf[4];
#pragma unroll
                        for (int d0 = 0; d0 < 4; ++d0) qf[d0] = *(const bf16x8*)(P0 + (size_t)qrow * P0P + 416 + hq * 64 + 16 * d0 + 8 * hh);
                        f32x16 o[2];
#pragma unroll
                        for (int i = 0; i < 16; ++i) { o[0][i] = 0.f; o[1][i] = 0.f; }
                        float m, lsum;
                        attn_run<64, 64, 64, true>(lds, tid, P0 + 928 + kvh * 64, P0P, P0 + 1056 + kvh * 64, P0P, ML + b * 256, b * 2048 + lat0, nt, qf, 0, q0l + qloc, lat0, false, o, m, lsum);
                        write_o<2>(lane, o, lsum, m, true, IN(19)[hq] * LOG2E, A + (size_t)(qrow - r) * 1024 + 512 + hq * 64, hh, lds + 65536 + wave * 4608);
                    }
                } }
            } else {
                { PHASE_IDS();
                const float lam = __expf(wave_sum(IN(30)[lane] * IN(31)[lane], lane)) - __expf(wave_sum(IN(32)[lane] * IN(33)[lane], lane)) + LAMBDA_INIT;
                for (int rep_ = 0; rep_ < REP_ATT1; ++rep_)
                for (int u = ((G & 7) == 0 ? (bid & 7) * (G >> 3) + (bid >> 3) : bid); u < 2048; u += G) {

                    const int r = lane & 31, hh = lane >> 5;
                    const int b = u >> 7, h = (u >> 4) & 7, qb = u & 15, mm = wave >> 2;
                    const int qrow = b * 2048 + 128 * qb + 32 * (wave & 3) + r;
                    bf16x8 qf[4];
#pragma unroll
                    for (int d0 = 0; d0 < 4; ++d0) qf[d0] = *(const bf16x8*)(P1 + (size_t)qrow * P1P + h * 128 + mm * 64 + 16 * d0 + 8 * hh);
                    f32x16 o[4];
#pragma unroll
                    for (int db = 0; db < 4; ++db)
#pragma unroll
                        for (int i = 0; i < 16; ++i) o[db][i] = 0.f;
                    float m, lsum;
                    attn_run<64, 128, 128, false>(lds, tid, P1 + 1024 + h * 128, P1P, P1 + 2048 + h * 128, P1P, ML + b * 256, b * 2048, 36, qf, mm * 128, 0, 0, false, o, m, lsum);
                    const float inv = 1.0f / (lsum + shx(lsum, 32, lane));
                    LAS float* stage = (LAS float*)lds + ((wave & 3) * 64) * 64 + lane;
                    asm volatile("" : "+v"(stage));
                    if (mm == 1) {
#pragma unroll
                        for (int db = 0; db < 4; ++db)
#pragma unroll
                            for (int i = 0; i < 16; ++i) stage[(db * 16 + i) * 64] = o[db][i] * inv;
                    }
                    __syncthreads();
                    if (mm == 0) {
                        float ss = 0.f;
#pragma unroll
                        for (int db = 0; db < 4; ++db)
#pragma unroll
                            for (int i = 0; i < 16; ++i) { const float x = o[db][i] * inv - lam * stage[(db * 16 + i) * 64]; o[db][i] = x; ss += x * x; }
                        ss += shx(ss, 32, lane);
                        const float rr = (1.0f - LAMBDA_INIT) / sqrtf(ss * (1.0f / 128.0f) + EPS);
                        LAS unsigned char* stg = lds + 96256 + wave * 8704;
                        LAS unsigned char* wp = stg + r * 272 + 8 * hh;
#pragma unroll
                        for (int db = 0; db < 4; ++db)
#pragma unroll
                            for (int g4 = 0; g4 < 4; ++g4) { const int d = 32 * db + 8 * g4 + 4 * hh; const f32x4 sg = *(const f32x4*)(IN(34) + d);
                                u32x2 w; w.x = pk_bf16(o[db][4 * g4] * rr * sg.x, o[db][4 * g4 + 1] * rr * sg.y); w.y = pk_bf16(o[db][4 * g4 + 2] * rr * sg.z, o[db][4 * g4 + 3] * rr * sg.w);
                                *(LAS u32x2*)(wp + 64 * db + 16 * g4) = w; }
                        asm volatile("s_waitcnt lgkmcnt(0)" ::: "memory");
                        bf16_t* obase = A + (size_t)(qrow - r) * 1024 + h * 128;
#pragma unroll
                        for (int i = 0; i < 8; ++i) { const int c = i * 64 + lane, row = c >> 4, ch = c & 15;
                            const u32x4 v = *(const LAS u32x4*)(stg + row * 272 + ch * 16); *(u32x4*)(obase + (size_t)row * 1024 + ch * 8) = v; }
                        asm volatile("s_waitcnt lgkmcnt(0)" ::: "memory");
                    }
                    __syncthreads();
                } }
            }
            GRID_BAR();
            {   PHASE_IDS();
                const int M = l ? ML : MT;
                pg8::Gemm g{A, W + (l ? WO_WOUT1 : WO_WOUT0), M, 1024, 1024, 1024}; pg8::SplitCtxOrder S; S.init(ML, 1024, G, bid, 16, l == 0);
                pg8::EpiResidPart<true, true> E{HL, HL, (_Float16*)(ws + WS_PART), modl + 5 * 1024, 1.0f, ML / 256};
                pg8::gemm_phase<pg8::EpiResidPart<true, true>, pg8::SplitCtxOrder, true, true>(lds, g, S, E, tid);
            }
            GRID_BAR();
        }
        const int Mf = (step == 3) ? ML : MT;
        {
#define NLNC() const void* nl = (step == 0) ? (const void*)IN(0) : (const void*)HL; const void* nc = (step == 0) ? (const void*)IN(2) : (const void*)HCh
            for (int rep_ = 0; rep_ < REP_NORM; ++rep_) { PHASE_IDS(); NLNC(); norm_phase(nl, step != 0, nc, step != 0, Mf, ng + (s ? 2048 : 0), modl, s ? 2 : 0, A, gw, NGW, lane, (step == 1 || step == 2) ? (const _Float16*)(ws + WS_PART) : (const _Float16*)nullptr, HCh); }
            GRID_BAR();
            {   PHASE_IDS(); pg8::Gemm g{A, W + WO_GU + (size_t)step * SZ_GU, Mf, 5632, 1024, 1024}; pg8::StaticOrder S; S.init(Mf, 5632, G, bid);
                pg8::EpiSwiglu E{U, DFF};
                for (int rep_ = 0; rep_ < REP_GU; ++rep_) pg8::gemm_phase<pg8::EpiSwiglu, pg8::StaticOrder, true, true>(lds, g, S, E, tid); }
            GRID_BAR();
            {   PHASE_IDS(); NLNC(); pg8::Gemm g{U, W + WO_WD + (size_t)step * SZ_WD, Mf, 1024, DFF, DFF}; pg8::SplitCtxOrder S; S.init(ML, 1024, G, bid, DFF / 64, step < 3);
                (void)nc; _Float16* partp = (_Float16*)(ws + WS_PART); const float* gatep = modl + (s ? 8 : 2) * 1024;
                if (step == 0) { pg8::EpiResidPart<false, true> E{nl, HL, partp, gatep, 0.5f, ML / 256}; pg8::gemm_phase<pg8::EpiResidPart<false, true>, pg8::SplitCtxOrder, true, true>(lds, g, S, E, tid); }
                else if (step == 3) { pg8::EpiResidPart<true, false> E{nl, OUT, partp, gatep, 0.5f, ML / 256}; pg8::gemm_phase<pg8::EpiResidPart<true, false>, pg8::SplitCtxOrder, true, true>(lds, g, S, E, tid); }
                else { pg8::EpiResidPart<true, true> E{nl, HL, partp, gatep, 0.5f, ML / 256}; pg8::gemm_phase<pg8::EpiResidPart<true, true>, pg8::SplitCtxOrder, true, true>(lds, g, S, E, tid); } }
            if (step < 3) GRID_BAR();
            for (int rep_ = 0; rep_ < REP_SYNC; ++rep_) GRID_BAR();
        }
    }
#undef IN
}

extern "C" void kernel_launch(void* const* d_in, const int* in_sizes, int n_in, void* d_out, int out_size, void* d_ws, size_t ws_size, hipStream_t stream) {
    static int grid_blocks = 0;
    if (grid_blocks == 0) {
        if (n_in != 36 || ws_size < WS_END) { fprintf(stderr, "kernel_launch: unexpected n_in %d / ws_size %zu\n", n_in, ws_size); grid_blocks = -1; return; }
        int dev = 0, cus = 0, per_cu = 0;
        hipGetDevice(&dev);
        hipDeviceGetAttribute(&cus, hipDeviceAttributeMultiprocessorCount, dev);
        hipFuncSetAttribute((const void*)fwd_megakernel, hipFuncAttributeMaxDynamicSharedMemorySize, LDS_BYTES);
        hipOccupancyMaxActiveBlocksPerMultiprocessor(&per_cu, (const void*)fwd_megakernel, 512, LDS_BYTES);
        if (per_cu < 1) per_cu = 1;
        grid_blocks = cus * per_cu;
        (void)hipGetLastError();
    }
    if (grid_blocks < 0) return;
    Args a{};
    for (int i = 0; i < 36; ++i) a.in[i] = (const float*)d_in[i];
    a.out = (float*)d_out; a.ws = (unsigned char*)d_ws;
    void* args[] = {&a};
    hipError_t e = hipLaunchCooperativeKernel((const void*)fwd_megakernel, dim3(grid_blocks), dim3(512), args, LDS_BYTES, stream);
    if (e != hipSuccess) fprintf(stderr, "cooperative launch failed: %s (grid %d)\n", hipGetErrorString(e), grid_blocks);
}
```

```cpp
#include <hip/hip_runtime.h>
#include <hip/hip_cooperative_groups.h>
#include <cstdio>
#include <cstdint>
namespace cg = cooperative_groups;
#pragma clang fp reassociate(on)
namespace pg8 {
#define PG8_LAS __attribute__((address_space(3)))
typedef unsigned short bf16_t;
typedef short bf16x8 __attribute__((ext_vector_type(8)));
typedef float f32x4 __attribute__((ext_vector_type(4)));
typedef unsigned u32x4 __attribute__((ext_vector_type(4)));
constexpr int BM = 256, BK = 64, HALF = 128, HTB = HALF * BK * 2  , STAGE_BYTES = 8 * HTB, NXCD = 8, WGM = 8;

__host__ __device__ __forceinline__ int lds_byte(int r, int c) { const int st = (r >> 4) * 2 + (c >> 5), rr = r & 15, cc = c & 31, ob = rr * 64 + cc * 2; return st * 1024 + (ob ^ (((ob >> 9) & 1) << 5)); }
__host__ __device__ __forceinline__ void stage_rc(int b, int& R, int& C) { const int st = b / 1024, sb = b % 1024, swz = sb ^ (((sb >> 9) & 1) << 5); R = (st >> 1) * 16 + swz / 64; C = (st & 1) * 32 + (swz % 64) / 2; }
__host__ __device__ __forceinline__ int perm32(int rho) { const int n = rho >> 4, i = rho & 15; return 8 * (i >> 2) + 4 * n + (i & 3); }

struct Unit { int pm, pn, kinfo; };
struct Gemm { const bf16_t* A; const bf16_t* Bt; int M, N, K, lda; };

struct StaticOrder {
    int nM, nN, nwg, G, c;
    __host__ __device__ void init(int M, int N, int G_, int c_) { nM = M / BM; nN = N / BM; nwg = nM * nN; G = G_; c = c_; }
    __host__ __device__ bool next(int i, Unit& u) const {
        const long L = (long)i * G + c; if (L >= nwg) return false;
        int wgid = (int)L; { const int q = nwg / NXCD, r = nwg % NXCD, xcd = wgid % NXCD, off = wgid / NXCD; wgid = (xcd < r ? xcd * (q + 1) : r * (q + 1) + (xcd - r) * q) + off; }
        const int nig = WGM * nN, gid = wgid / nig, fm = gid * WGM, gsz = (nM - fm) < WGM ? (nM - fm) : WGM;
        u.pm = fm + ((wgid % nig) % gsz); u.pn = (wgid % nig) / gsz; u.kinfo = 0; return true;
    }
    __device__ __forceinline__ void a_ready(const Unit&) const {}
    __device__ __forceinline__ void done(const Unit&) const {}
};


struct SplitCtxOrder {
    StaticOrder lat; int nmine, nN_, G_, c_, nkA, nkB, nparts;
    __host__ __device__ void init(int Mlat, int N, int G, int c, int ntK, bool with_ctx) { lat.init(Mlat, N, G, c); nmine = c < lat.nwg ? (lat.nwg - c + G - 1) / G : 0; nN_ = N / BM; G_ = G; c_ = c;
        nkA = ((ntK / 4 + 1) / 2) * 2; nkB = (ntK - 2 * nkA) / 2; nparts = with_ctx ? 16 * nN_ * 4 : 0; }
    __host__ __device__ bool next(int i, Unit& u) const {
        if (i < nmine) return lat.next(i, u);
        const int idx = (i - nmine) * G_ + c_; if (idx >= nparts) return false;
        const int kp = idx & 3, tile = idx >> 2;
        u.pm = lat.nM + tile / nN_; u.pn = tile % nN_;
        const int k0 = kp < 2 ? kp * nkA : 2 * nkA + (kp - 2) * nkB, nk = kp < 2 ? nkA : nkB; u.kinfo = k0 | (nk << 8) | (kp << 16); return true;
    }
    __device__ __forceinline__ void a_ready(const Unit&) const {}
    __device__ __forceinline__ void done(const Unit&) const {}
};
__device__ __forceinline__ unsigned cvt_pk_bf16(float lo, float hi) { unsigned r; asm volatile("v_cvt_pk_bf16_f32 %0, %1, %2" : "=v"(r) : "v"(lo), "v"(hi)); return r; }
typedef float f32x2 __attribute__((ext_vector_type(2)));
__device__ __forceinline__ unsigned pk_bf16(float lo, float hi) { typedef __bf16 b2_t __attribute__((ext_vector_type(2))); f32x2 v = {lo, hi}; b2_t b = __builtin_convertvector(v, b2_t); return __builtin_bit_cast(unsigned, b); }
__device__ __forceinline__ float silu_f(float x) { return x * __builtin_amdgcn_rcpf(1.0f + __builtin_amdgcn_exp2f(-1.4426950408889634f * x)); }

struct EpiStoreBf16 {
    static constexpr bool PERM = true, AFTER_DRAIN = false;
    bf16_t* O; int ldc;
    __device__ __forceinline__ void operator()(const f32x4 (&acc)[2][2][4][2], const Unit& u, int wr, int wc, int fr, int fq) const {
        const int row0 = u.pm * BM + wr * 64 + fr, col0 = u.pn * BM + wc * 32 + 8 * fq;
#pragma unroll
        for (int ai = 0; ai < 2; ++ai)
#pragma unroll
            for (int m = 0; m < 4; ++m) { bf16_t* rowp = O + (size_t)(row0 + ai * HALF + m * 16) * ldc + col0;
#pragma unroll
                for (int bj = 0; bj < 2; ++bj) { const f32x4 v0 = acc[ai][bj][m][0], v1 = acc[ai][bj][m][1];
                    u32x4 w; w.x = pk_bf16(v0[0], v0[1]); w.y = pk_bf16(v0[2], v0[3]); w.z = pk_bf16(v1[0], v1[1]); w.w = pk_bf16(v1[2], v1[3]);
                    *(u32x4*)(rowp + bj * HALF) = w; } }
    }
};
struct EpiSwiglu {
    static constexpr bool PERM = true, AFTER_DRAIN = false;
    bf16_t* U; int ldu;
    __device__ __forceinline__ void operator()(const f32x4 (&acc)[2][2][4][2], const Unit& u, int wr, int wc, int fr, int fq) const {
        const int row0 = u.pm * BM + wr * 64 + fr, col0 = u.pn * HALF + wc * 32 + 8 * fq;
#pragma unroll
        for (int ai = 0; ai < 2; ++ai)
#pragma unroll
            for (int m = 0; m < 4; ++m) { bf16_t* rowp = U + (size_t)(row0 + ai * HALF + m * 16) * ldu + col0;
                const f32x4 g0 = acc[ai][0][m][0], g1 = acc[ai][0][m][1], u0 = acc[ai][1][m][0], u1 = acc[ai][1][m][1];
                u32x4 w;
                w.x = pk_bf16(silu_f(g0[0]) * u0[0], silu_f(g0[1]) * u0[1]); w.y = pk_bf16(silu_f(g0[2]) * u0[2], silu_f(g0[3]) * u0[3]);
                w.z = pk_bf16(silu_f(g1[0]) * u1[0], silu_f(g1[1]) * u1[1]); w.w = pk_bf16(silu_f(g1[2]) * u1[2], silu_f(g1[3]) * u1[3]);
                *(u32x4*)rowp = w; }
    }
};
struct EpiResid {
    static constexpr bool PERM = false, AFTER_DRAIN = false;
    const float* base_lat; const float* base_ctx; float* out_lat; float* out_ctx; const float* gate; float gs;
    __device__ __forceinline__ void operator()(const f32x4 (&acc)[2][2][4][2], const Unit& u, int wr, int wc, int fr, int fq) const {
        const bool isctx = u.pm >= 128; const int bidx = isctx ? 16 : (u.pm >> 3);
        const float* base = isctx ? base_ctx : base_lat; float* out = isctx ? out_ctx : out_lat;
        const int rloc = (isctx ? (u.pm - 128) : u.pm) * BM + wr * 64 + fr, col0 = u.pn * BM + wc * 32 + 4 * fq;
        f32x4 gv[2][2];
#pragma unroll
        for (int bj = 0; bj < 2; ++bj)
#pragma unroll
            for (int n = 0; n < 2; ++n) gv[bj][n] = *(const f32x4*)(gate + (size_t)bidx * 9216 + col0 + bj * HALF + n * 16) * gs;
#pragma unroll
        for (int ai = 0; ai < 2; ++ai)
#pragma unroll
            for (int m = 0; m < 4; ++m) { const size_t off = (size_t)(rloc + ai * HALF + m * 16) * 1024 + col0;
#pragma unroll
                for (int bj = 0; bj < 2; ++bj)
#pragma unroll
                    for (int n = 0; n < 2; ++n) { const f32x4 b = *(const f32x4*)(base + off + bj * HALF + n * 16);
                        *(f32x4*)(out + off + bj * HALF + n * 16) = b + gv[bj][n] * acc[ai][bj][m][n]; } }
    }
};

typedef _Float16 f16x8 __attribute__((ext_vector_type(8)));
typedef _Float16 f16x4 __attribute__((ext_vector_type(4)));
template <bool BASE16, bool OUT16> struct EpiResidPart {
    static constexpr bool PERM = true, AFTER_DRAIN = false;
    const void* base_lat; void* out_lat; _Float16* part; const float* gate; float gs; int nMlat;
    __device__ __forceinline__ void operator()(const f32x4 (&acc)[2][2][4][2], const Unit& u, int wr, int wc, int fr, int fq) const {
        const bool isctx = u.pm >= nMlat; const int bidx = isctx ? 16 : (u.pm >> 3);
        const int rloc = (isctx ? (u.pm - nMlat) : u.pm) * BM + wr * 64 + fr, col0 = u.pn * BM + wc * 32 + 8 * fq;
        f32x4 gv[2][2];
#pragma unroll
        for (int bj = 0; bj < 2; ++bj)
#pragma unroll
            for (int n = 0; n < 2; ++n) gv[bj][n] = *(const f32x4*)(gate + (size_t)bidx * 9216 + col0 + bj * HALF + n * 4) * gs;
        if (!isctx) {
#pragma unroll
            for (int ai = 0; ai < 2; ++ai) {
                f32x4 pre[4][2][2];
#pragma unroll
                for (int m = 0; m < 4; ++m) { const size_t off = (size_t)(rloc + ai * HALF + m * 16) * 1024 + col0;
#pragma unroll
                    for (int bj = 0; bj < 2; ++bj) {
                        if (BASE16) { const f16x8 hb = *(const f16x8*)((const _Float16*)base_lat + off + bj * HALF);
                            pre[m][bj][0] = (f32x4){(float)hb[0], (float)hb[1], (float)hb[2], (float)hb[3]}; pre[m][bj][1] = (f32x4){(float)hb[4], (float)hb[5], (float)hb[6], (float)hb[7]}; }
                        else { pre[m][bj][0] = *(const f32x4*)((const float*)base_lat + off + bj * HALF); pre[m][bj][1] = *(const f32x4*)((const float*)base_lat + off + bj * HALF + 4); } } }
                asm volatile("" ::: "memory");
#pragma unroll
                for (int m = 0; m < 4; ++m) { const size_t off = (size_t)(rloc + ai * HALF + m * 16) * 1024 + col0;
#pragma unroll
                    for (int bj = 0; bj < 2; ++bj) { const f32x4 o0 = pre[m][bj][0] + gv[bj][0] * acc[ai][bj][m][0], o1 = pre[m][bj][1] + gv[bj][1] * acc[ai][bj][m][1];
                        if (OUT16) { f16x8 ho; ho[0] = (_Float16)o0[0]; ho[1] = (_Float16)o0[1]; ho[2] = (_Float16)o0[2]; ho[3] = (_Float16)o0[3]; ho[4] = (_Float16)o1[0]; ho[5] = (_Float16)o1[1]; ho[6] = (_Float16)o1[2]; ho[7] = (_Float16)o1[3];
                            *(f16x8*)((_Float16*)out_lat + off + bj * HALF) = ho; }
                        else { *(f32x4*)((float*)out_lat + off + bj * HALF) = o0; *(f32x4*)((float*)out_lat + off + bj * HALF + 4) = o1; } } }
                asm volatile("" ::: "memory");
            }
        } else {
            _Float16* pp = part + (size_t)(u.kinfo >> 16) * (4096 * 1024);
#pragma unroll
            for (int ai = 0; ai < 2; ++ai)
#pragma unroll
                for (int m = 0; m < 4; ++m) { const size_t off = (size_t)(rloc + ai * HALF + m * 16) * 1024 + col0;
#pragma unroll
                    for (int bj = 0; bj < 2; ++bj) { const f32x4 p0 = gv[bj][0] * acc[ai][bj][m][0], p1 = gv[bj][1] * acc[ai][bj][m][1];
                        f16x8 hp; hp[0] = (_Float16)p0[0]; hp[1] = (_Float16)p0[1]; hp[2] = (_Float16)p0[2]; hp[3] = (_Float16)p0[3]; hp[4] = (_Float16)p1[0]; hp[5] = (_Float16)p1[1]; hp[6] = (_Float16)p1[2]; hp[7] = (_Float16)p1[3];
                        *(f16x8*)(pp + off + bj * HALF) = hp; } }
        }
    }
};

struct EpiQKV1 {
    static constexpr bool PERM = true, AFTER_DRAIN = false;
    bf16_t* P; int ldp; const float* qg; const float* kg; const float* cs; const float* sn; int nMlat; float qscale, eps;
    __device__ __forceinline__ void operator()(const f32x4 (&acc)[2][2][4][2], const Unit& u, int wr, int wc, int fr, int fq) const {
        const int row0 = u.pm * BM + wr * 64 + fr, colb = u.pn * BM + wc * 64 + 8 * fq;
        if (u.pn >= 8) {
#pragma unroll
            for (int ai = 0; ai < 2; ++ai)
#pragma unroll
                for (int m = 0; m < 4; ++m) { bf16_t* rowp = P + (size_t)(row0 + ai * HALF + m * 16) * ldp + colb;
#pragma unroll
                    for (int bj = 0; bj < 2; ++bj) { const f32x4 v0 = acc[ai][bj][m][0], v1 = acc[ai][bj][m][1];
                        u32x4 w; w.x = pk_bf16(v0[0], v0[1]); w.y = pk_bf16(v0[2], v0[3]); w.z = pk_bf16(v1[0], v1[1]); w.w = pk_bf16(v1[2], v1[3]);
                        *(u32x4*)(rowp + 32 * bj) = w; } }
            return;
        }
        const bool isq = u.pn < 4, lat = u.pm < nMlat; const float* g = isq ? qg : kg; const float osc = isq ? qscale : 1.0f;
        f32x4 g1[2], g2[2];
#pragma unroll
        for (int n = 0; n < 2; ++n) { g1[n] = *(const f32x4*)(g + 8 * fq + 4 * n) * osc; g2[n] = *(const f32x4*)(g + 32 + 8 * fq + 4 * n) * osc; }
        const int lane = fq * 16 + fr;
#pragma unroll
        for (int ai = 0; ai < 2; ++ai)
#pragma unroll
            for (int m = 0; m < 4; ++m) { const int row = row0 + ai * HALF + m * 16;
                const f32x4 a0 = acc[ai][0][m][0], a1 = acc[ai][0][m][1], b0 = acc[ai][1][m][0], b1 = acc[ai][1][m][1];
                float ss = ((a0[0] * a0[0] + a0[1] * a0[1]) + (a0[2] * a0[2] + a0[3] * a0[3])) + ((a1[0] * a1[0] + a1[1] * a1[1]) + (a1[2] * a1[2] + a1[3] * a1[3]))
                         + ((b0[0] * b0[0] + b0[1] * b0[1]) + (b0[2] * b0[2] + b0[3] * b0[3])) + ((b1[0] * b1[0] + b1[1] * b1[1]) + (b1[2] * b1[2] + b1[3] * b1[3]));
                ss += __int_as_float(__builtin_amdgcn_ds_bpermute((lane ^ 16) << 2, __float_as_int(ss)));
                ss += __int_as_float(__builtin_amdgcn_ds_bpermute((lane ^ 32) << 2, __float_as_int(ss)));
                const float r = 1.0f / sqrtf(ss * (1.0f / 64.0f) + eps);
                f32x4 y10 = a0 * r * g1[0], y11 = a1 * r * g1[1], y20 = b0 * r * g2[0], y21 = b1 * r * g2[1];
                if (lat) { const int t = row & 2047;
                    const f32x4 c0 = *(const f32x4*)(cs + t * 32 + 8 * fq), c1 = *(const f32x4*)(cs + t * 32 + 8 * fq + 4), s0 = *(const f32x4*)(sn + t * 32 + 8 * fq), s1 = *(const f32x4*)(sn + t * 32 + 8 * fq + 4);
                    const f32x4 o10 = y10 * c0 - y20 * s0, o20 = y10 * s0 + y20 * c0, o11 = y11 * c1 - y21 * s1, o21 = y11 * s1 + y21 * c1;
                    y10 = o10; y20 = o20; y11 = o11; y21 = o21; }
                bf16_t* rowp = P + (size_t)row * ldp + colb;
                u32x4 w1; w1.x = pk_bf16(y10[0], y10[1]); w1.y = pk_bf16(y10[2], y10[3]); w1.z = pk_bf16(y11[0], y11[1]); w1.w = pk_bf16(y11[2], y11[3]);
                u32x4 w2; w2.x = pk_bf16(y20[0], y20[1]); w2.y = pk_bf16(y20[2], y20[3]); w2.z = pk_bf16(y21[0], y21[1]); w2.w = pk_bf16(y21[2], y21[3]);
                *(u32x4*)(rowp) = w1; *(u32x4*)(rowp + 32) = w2; }
    }
};

template <class Epi, class Sched, bool ALIGN_EPI = false, bool SP2 = false>
__device__ __forceinline__ void gemm_phase(PG8_LAS unsigned char* lds, const Gemm g, const Sched& S, const Epi& E, int tid_in) {
    const int tid = tid_in, wid = __builtin_amdgcn_readfirstlane(tid >> 6), lane = tid & 63, wr = wid >> 2, wc = wid & 3, fr = lane & 15, fq = lane >> 4;
    const int K = g.K, nt = K / BK;
    unsigned voffA[2], voffB[2];
#pragma unroll
    for (int i = 0; i < 2; ++i) { int R, C; stage_rc(tid * 16 + i * 8192, R, C); const int Rb = Epi::PERM ? ((R & ~31) + perm32(R & 31)) : R;
        voffA[i] = (unsigned)(R * g.lda + C) * 2u; voffB[i] = (unsigned)(Rb * K + C) * 2u; }
    const size_t kstep = (size_t)(BK * 2);
    const size_t hstepB = (size_t)HALF * K * 2, hstepA = (size_t)HALF * g.lda * 2;
    const size_t tstepA = 2 * hstepA, tstepB = 2 * hstepB;
    const unsigned ldsw = (unsigned)wid * 1024u;
    const int aoff = lds_byte(wr * 64 + fr, fq * 8), boff = lds_byte(wc * 32 + fr, fq * 8);
#define PG8_SA(b, h) (((b) * 2 + (h)) * HTB)
#define PG8_SB(b, h) ((4 + (b) * 2 + (h)) * HTB)
#define PG8_STAGE(bufoff, gbase, voff) do { _Pragma("unroll") for (int _i = 0; _i < 2; ++_i) \
        __builtin_amdgcn_global_load_lds((const unsigned*)((const char*)(gbase) + (voff)[_i]), (PG8_LAS unsigned*)(lds + (bufoff) + ldsw + _i * 8192), 16, 0, 0); } while (0)
#define PG8_LDA(dst, b, h) do { _Pragma("unroll") for (int m = 0; m < 4; ++m) _Pragma("unroll") for (int k = 0; k < 2; ++k) dst[m][k] = *(const PG8_LAS bf16x8*)(lds + PG8_SA(b, h) + aoff + m * 2048 + k * 1024); } while (0)
#define PG8_LDB(dst, b, h) do { _Pragma("unroll") for (int n = 0; n < 2; ++n) _Pragma("unroll") for (int k = 0; k < 2; ++k) dst[n][k] = *(const PG8_LAS bf16x8*)(lds + PG8_SB(b, h) + boff + n * 2048 + k * 1024); } while (0)
#define PG8_MMA(ai, bj, At, Bt) do { __builtin_amdgcn_s_setprio(1); _Pragma("unroll") for (int m = 0; m < 4; ++m) _Pragma("unroll") for (int n = 0; n < 2; ++n) _Pragma("unroll") for (int k = 0; k < 2; ++k) \
        acc[ai][bj][m][n] = __builtin_amdgcn_mfma_f32_16x16x32_bf16(Bt[n][k], At[m][k], acc[ai][bj][m][n], 0, 0, 0); __builtin_amdgcn_s_setprio(0); } while (0)
#define PG8_WAIT_V(n) asm volatile("s_waitcnt vmcnt(" #n ")" ::: "memory")
#define PG8_WAIT_L(n) asm volatile("s_waitcnt lgkmcnt(" #n ")" ::: "memory")
#define PG8_BAR __builtin_amdgcn_s_barrier()
#define PG8_SCHED __builtin_amdgcn_sched_barrier(0)
    Unit cur, nxt; int ui = 0;
    if (!S.next(0, cur)) return;
    f32x4 acc[2][2][4][2];
#pragma unroll
    for (int a = 0; a < 2; ++a)
#pragma unroll
        for (int b = 0; b < 2; ++b)
#pragma unroll
            for (int m = 0; m < 4; ++m)
#pragma unroll
                for (int n = 0; n < 2; ++n) acc[a][b][m][n] = (f32x4){0.f, 0.f, 0.f, 0.f};
    bf16x8 At[4][2], B0[2][2], B1[2][2];
    const char* cA = (const char*)g.A + (size_t)cur.pm * tstepA + (size_t)(cur.kinfo & 255) * kstep; const char* cB = (const char*)g.Bt + (size_t)cur.pn * tstepB + (size_t)(cur.kinfo & 255) * kstep;
    S.a_ready(cur);
    if constexpr (SP2) {
        PG8_STAGE(PG8_SB(0, 0), cB, voffB); PG8_STAGE(PG8_SB(0, 1), cB + hstepB, voffB); PG8_STAGE(PG8_SA(0, 0), cA, voffA); PG8_STAGE(PG8_SA(0, 1), cA + hstepA, voffA);
        if (wr == 1) PG8_BAR;
        PG8_WAIT_V(2); PG8_BAR;
        PG8_STAGE(PG8_SB(1, 0), cB + kstep, voffB); PG8_STAGE(PG8_SA(1, 0), cA + kstep, voffA); PG8_STAGE(PG8_SB(1, 1), cB + hstepB + kstep, voffB);
        PG8_WAIT_V(6); PG8_BAR;
    } else {
        PG8_STAGE(PG8_SB(0, 0), cB, voffB); PG8_STAGE(PG8_SA(0, 0), cA, voffA); PG8_STAGE(PG8_SB(0, 1), cB + hstepB, voffB); PG8_STAGE(PG8_SA(0, 1), cA + hstepA, voffA);
        if (wr == 1) PG8_BAR;
        PG8_WAIT_V(4); PG8_BAR;
        PG8_STAGE(PG8_SB(1, 0), cB + kstep, voffB); PG8_STAGE(PG8_SA(1, 0), cA + kstep, voffA); PG8_STAGE(PG8_SB(1, 1), cB + hstepB + kstep, voffB);
        PG8_WAIT_V(6); PG8_BAR;
    }
    for (;;) {
        const bool has_next = S.next(ui + 1, nxt);
        const char* nA = has_next ? (const char*)g.A + (size_t)nxt.pm * tstepA + (size_t)(nxt.kinfo & 255) * kstep : cA; const char* nB = has_next ? (const char*)g.Bt + (size_t)nxt.pn * tstepB + (size_t)(nxt.kinfo & 255) * kstep : cB;
        const int cnt_ = cur.kinfo ? ((cur.kinfo >> 8) & 255) : nt;
        for (int t = 0; t < cnt_; t += 2) {
            const bool last = (t == cnt_ - 2);
            const char* a1 = cA + (size_t)(t + 1) * kstep;
            const char* a2 = last ? nA : cA + (size_t)(t + 2) * kstep; const char* b2 = last ? nB : cB + (size_t)(t + 2) * kstep;
            const char* a3 = a2 + kstep; const char* b3 = b2 + kstep;
            if (last && has_next) S.a_ready(nxt);
            if constexpr (SP2) {
            PG8_LDB(B0, 0, 0); PG8_LDB(B1, 0, 1); PG8_SCHED; PG8_LDA(At, 0, 0); PG8_STAGE(PG8_SA(1, 1), a1 + hstepA, voffA);
            PG8_WAIT_V(8); PG8_WAIT_L(0); PG8_BAR; PG8_MMA(0, 0, At, B0); PG8_MMA(0, 1, At, B1); PG8_BAR; PG8_SCHED;
            PG8_LDA(At, 0, 1); PG8_STAGE(PG8_SB(0, 0), b2, voffB); PG8_STAGE(PG8_SB(0, 1), b2 + hstepB, voffB); PG8_STAGE(PG8_SA(0, 0), a2, voffA);
            PG8_WAIT_V(8); PG8_WAIT_L(0); PG8_BAR; PG8_MMA(1, 0, At, B0); PG8_MMA(1, 1, At, B1); PG8_BAR; PG8_SCHED;
            PG8_LDB(B0, 1, 0); PG8_LDB(B1, 1, 1); PG8_SCHED; PG8_LDA(At, 1, 0); PG8_STAGE(PG8_SA(0, 1), a2 + hstepA, voffA);
            PG8_WAIT_V(8); PG8_WAIT_L(0); PG8_BAR; PG8_MMA(0, 0, At, B0); PG8_MMA(0, 1, At, B1); PG8_BAR; PG8_SCHED;
            PG8_LDA(At, 1, 1); PG8_STAGE(PG8_SB(1, 0), b3, voffB); PG8_STAGE(PG8_SB(1, 1), b3 + hstepB, voffB); PG8_STAGE(PG8_SA(1, 0), a3, voffA);
            PG8_WAIT_V(8); PG8_WAIT_L(0); PG8_BAR; PG8_MMA(1, 0, At, B0); PG8_MMA(1, 1, At, B1); PG8_BAR; PG8_SCHED;
            } else {
            PG8_LDB(B0, 0, 0); PG8_SCHED; PG8_LDA(At, 0, 0); PG8_STAGE(PG8_SA(1, 1), a1 + hstepA, voffA);
            PG8_WAIT_L(8); PG8_BAR; PG8_WAIT_L(0); PG8_MMA(0, 0, At, B0); PG8_BAR; PG8_SCHED;
            PG8_LDB(B1, 0, 1); PG8_STAGE(PG8_SB(0, 0), b2, voffB);
            PG8_BAR; PG8_WAIT_L(0); PG8_MMA(0, 1, At, B1); PG8_BAR;
            PG8_LDA(At, 0, 1); PG8_STAGE(PG8_SA(0, 0), a2, voffA);
            PG8_BAR; PG8_WAIT_L(0); PG8_MMA(1, 0, At, B0); PG8_BAR; PG8_SCHED;
            PG8_STAGE(PG8_SB(0, 1), b2 + hstepB, voffB);
            PG8_WAIT_V(6); PG8_BAR; PG8_MMA(1, 1, At, B1); PG8_BAR;
            PG8_LDB(B0, 1, 0); PG8_SCHED; PG8_LDA(At, 1, 0); PG8_STAGE(PG8_SA(0, 1), a2 + hstepA, voffA);
            PG8_WAIT_L(8); PG8_BAR; PG8_WAIT_L(0); PG8_MMA(0, 0, At, B0); PG8_BAR; PG8_SCHED;
            PG8_LDB(B1, 1, 1); PG8_STAGE(PG8_SB(1, 0), b3, voffB);
            PG8_BAR; PG8_WAIT_L(0); PG8_MMA(0, 1, At, B1); PG8_BAR;
            PG8_LDA(At, 1, 1); PG8_STAGE(PG8_SA(1, 0), a3, voffA);
            PG8_BAR; PG8_WAIT_L(0); PG8_MMA(1, 0, At, B0); PG8_BAR; PG8_SCHED;
            PG8_STAGE(PG8_SB(1, 1), b3 + hstepB, voffB);
            PG8_WAIT_V(6); PG8_BAR; PG8_MMA(1, 1, At, B1); PG8_BAR;
            }
        }
        if constexpr (ALIGN_EPI) { if (wr == 0) PG8_BAR; }
        if constexpr (!Epi::AFTER_DRAIN) { E(acc, cur, wr, wc, fr, fq); S.done(cur); }
        if (!has_next) break;
#pragma unroll
        for (int a = 0; a < 2; ++a)
#pragma unroll
            for (int b = 0; b < 2; ++b)
#pragma unroll
                for (int m = 0; m < 4; ++m)
#pragma unroll
                    for (int n = 0; n < 2; ++n) acc[a][b][m][n] = (f32x4){0.f, 0.f, 0.f, 0.f};
        cur = nxt; cA = nA; cB = nB; ++ui;
        if constexpr (ALIGN_EPI) { if (wr == 1) PG8_BAR; }
    }
    PG8_WAIT_V(0);
    if constexpr (!ALIGN_EPI) { if (wr == 0) PG8_BAR; }
    PG8_BAR;
    if constexpr (Epi::AFTER_DRAIN) { E.fused(acc, cur, wr, wc, fr, fq, lds, wid, lane); S.done(cur); }
#undef PG8_SA
#undef PG8_SB
#undef PG8_STAGE
#undef PG8_LDA
#undef PG8_LDB
#undef PG8_MMA
#undef PG8_WAIT_V
#undef PG8_WAIT_L
#undef PG8_BAR
#undef PG8_SCHED
}
}

#define REP_ATT0 1
#define REP_ATT1 1
#define REP_GU 1
#define REP_NORM 1
#define REP_SYNC 0
#define LAS __attribute__((address_space(3)))
typedef unsigned short bf16_t;
typedef short bf16x8 __attribute__((ext_vector_type(8)));
typedef short s16x4 __attribute__((ext_vector_type(4)));
typedef short v4i16_t __attribute__((ext_vector_type(4)));
typedef float f32x16 __attribute__((ext_vector_type(16)));
typedef float f32x4 __attribute__((ext_vector_type(4)));
typedef unsigned u32x4 __attribute__((ext_vector_type(4)));
typedef unsigned u32x2 __attribute__((ext_vector_type(2)));
using pg8::pk_bf16;

constexpr int D = 1024, NB = 16, SEQ = 2048, CTX = 256, DFF = 2816;
constexpr int ML = NB * SEQ, MC = NB * CTX, MT = ML + MC;
constexpr int P0W = 1280, P1W = 3072;
constexpr int P0P = 1408, P1P = 3200, KVP = 1152, MKP = 896;
constexpr float EPS = 1e-6f, LOG2E = 1.4426950408889634f;
constexpr float LAMBDA_INIT = 0.35550906759096927f;
constexpr size_t MiB = 1u << 20;
constexpr size_t WS_MOD = 0;
constexpr size_t WS_ROPE = 2 * MiB;
constexpr size_t WS_BAR = 3 * MiB;
constexpr size_t WS_HC = 4 * MiB;
constexpr size_t WS_W = 20 * MiB;
constexpr size_t WS_HL = 100 * MiB, WS_HCH = 164 * MiB;
constexpr size_t WS_A = 100 * MiB;
constexpr size_t WS_P = 172 * MiB;
constexpr size_t WS_QF = 271 * MiB, WS_KVF = 325 * MiB;
constexpr size_t WS_MK = 406 * MiB;
constexpr size_t WS_PART = 400 * MiB;
constexpr size_t WS_END = 469 * MiB;
static_assert((size_t)MT * P0P * 2 <= 99 * MiB && (size_t)MT * KVP * 2 <= 81 * MiB && (size_t)MT * MKP * 2 <= 63 * MiB && (size_t)MT * P1P * 2 <= 225 * MiB && (size_t)MT * 768 * 2 <= 54 * MiB, "ws map");
constexpr size_t SZ_GU = (size_t)5632 * 1024, SZ_WD = (size_t)1024 * 2816;
constexpr size_t WO_GU = 0, WO_WD = WO_GU + 4 * SZ_GU, WO_WIN0 = WO_WD + 4 * SZ_WD, WO_WQB = WO_WIN0 + (size_t)1280 * 1024, WO_WKVB = WO_WQB + (size_t)768 * 256,
                 WO_WOUT0 = WO_WKVB + (size_t)1024 * 128, WO_WIN1 = WO_WOUT0 + (size_t)1024 * 1024, WO_WOUT1 = WO_WIN1 + (size_t)3072 * 1024, WO_END = WO_WOUT1 + (size_t)1024 * 1024;
static_assert(WO_END * 2 <= 80 * MiB, "weights fit");
constexpr int LDS_BYTES = 131072 + 1024;

__device__ __forceinline__ float bflo(unsigned u) { return __uint_as_float(u << 16); }
__device__ __forceinline__ float bfhi(unsigned u) { return __uint_as_float(u & 0xffff0000u); }
__device__ __forceinline__ float shx(float v, int mask, int lane) { return __int_as_float(__builtin_amdgcn_ds_bpermute((lane ^ mask) << 2, __float_as_int(v))); }
__device__ __forceinline__ float wave_sum(float v, int lane) {
#pragma unroll
    for (int o = 1; o < 64; o <<= 1) v += shx(v, o, lane);
    return v;
}
#define LDS_WAIT() asm volatile("s_waitcnt lgkmcnt(0)" ::: "memory")

__device__ __forceinline__ void conv_item(const float* __restrict__ W, int K, int N, bf16_t* WT, int mode, LAS float* scr, int item, int lane) {
    const int nblk = N / 32, kb = item / nblk, nb = item % nblk, k0 = 64 * kb, n0 = 32 * nb;
#pragma unroll 8
    for (int i = 0; i < 32; ++i) { const int kk = 2 * i + (lane >> 5); scr[kk * 33 + (lane & 31)] = W[(size_t)(k0 + kk) * N + n0 + (lane & 31)]; }
    LDS_WAIT();
    const int drow0 = mode == 0 ? n0 : mode == 3 ? ((n0 & ~255) + 128 * ((n0 >> 5) & 1) + 32 * ((n0 >> 6) & 3))
                                         : ((n0 >> 7) * 256 + (n0 & 127) + (mode == 2 ? 128 : 0));
    const int c = lane & 7;
#pragma unroll
    for (int j = 0; j < 4; ++j) { const int n = (lane >> 3) + 8 * j; const LAS float* s = scr + (8 * c) * 33 + n;
        u32x4 o; o.x = pk_bf16(s[0 * 33], s[1 * 33]); o.y = pk_bf16(s[2 * 33], s[3 * 33]); o.z = pk_bf16(s[4 * 33], s[5 * 33]); o.w = pk_bf16(s[6 * 33], s[7 * 33]);
        *(u32x4*)(WT + (size_t)(drow0 + n) * K + k0 + 8 * c) = o; }
    LDS_WAIT();
}
__device__ __forceinline__ void sincos_d(double a, float& sn, float& cs) {
    const double k = __builtin_rint(a * 0.63661977236758134308); const double r = a - k * 1.57079632679489661923; const double r2 = r * r;
    const double s = r * (1.0 + r2 * (-1.0 / 6 + r2 * (1.0 / 120 + r2 * (-1.0 / 5040 + r2 * (1.0 / 362880 + r2 * (-1.0 / 39916800))))));
    const double c = 1.0 + r2 * (-0.5 + r2 * (1.0 / 24 + r2 * (-1.0 / 720 + r2 * (1.0 / 40320 + r2 * (-1.0 / 3628800 + r2 * (1.0 / 479001600))))));
    const int q = ((int)k) & 3;
    const double so = (q == 0) ? s : (q == 1) ? c : (q == 2) ? -s : -c;
    const double co = (q == 0) ? c : (q == 1) ? -s : (q == 2) ? -c : s;
    sn = (float)so; cs = (float)co;
}

typedef _Float16 f16x4m __attribute__((ext_vector_type(4)));
__device__ __forceinline__ void norm_phase(const void* lat, bool lat16, const void* ctxp, bool ctx16, int nrows, const float* __restrict__ g, const float* __restrict__ modl, int k, bf16_t* A, int gw, int NGW, int lane, const _Float16* part, _Float16* ctx_out) {
    for (int row = gw; row < nrows; row += NGW) {
        const bool isctx = row >= ML; const size_t ro = (size_t)(isctx ? row - ML : row) * D + 4 * lane; const void* src = isctx ? ctxp : lat; const bool s16 = isctx ? ctx16 : lat16;
        const int bidx = isctx ? 16 : (row >> 11);
        const float* sh = modl + (size_t)bidx * 9216 + (3 * k) * 1024; const float* sc = sh + 1024;
        f32x4 v[4]; float ss = 0.f;
        if (s16) {
#pragma unroll
            for (int j = 0; j < 4; ++j) { const f16x4m hv = *(const f16x4m*)((const _Float16*)src + ro + 256 * j); v[j] = (f32x4){(float)hv[0], (float)hv[1], (float)hv[2], (float)hv[3]}; }
        } else {
#pragma unroll
            for (int j = 0; j < 4; ++j) v[j] = *(const f32x4*)((const float*)src + ro + 256 * j);
        }
        if (isctx && part != nullptr) {
#pragma unroll
            for (int j = 0; j < 4; ++j) { const f16x4m q0 = *(const f16x4m*)(part + ro + 256 * j), q1 = *(const f16x4m*)(part + (size_t)4096 * 1024 + ro + 256 * j), q2 = *(const f16x4m*)(part + (size_t)2 * 4096 * 1024 + ro + 256 * j), q3 = *(const f16x4m*)(part + (size_t)3 * 4096 * 1024 + ro + 256 * j);
                const f32x4 p0 = (f32x4){(float)q0[0], (float)q0[1], (float)q0[2], (float)q0[3]}, p1 = (f32x4){(float)q1[0], (float)q1[1], (float)q1[2], (float)q1[3]}, p2 = (f32x4){(float)q2[0], (float)q2[1], (float)q2[2], (float)q2[3]}, p3 = (f32x4){(float)q3[0], (float)q3[1], (float)q3[2], (float)q3[3]};
                v[j] = v[j] + ((p0 + p1) + (p2 + p3)); f16x4m ho; ho[0] = (_Float16)v[j][0]; ho[1] = (_Float16)v[j][1]; ho[2] = (_Float16)v[j][2]; ho[3] = (_Float16)v[j][3]; *(f16x4m*)(ctx_out + ro + 256 * j) = ho; } }
#pragma unroll
        for (int j = 0; j < 4; ++j) ss += (v[j].x * v[j].x + v[j].y * v[j].y) + (v[j].z * v[j].z + v[j].w * v[j].w);
        ss = wave_sum(ss, lane); const float r = 1.0f / sqrtf(ss * (1.0f / 1024.0f) + EPS);
#pragma unroll
        for (int j = 0; j < 4; ++j) { const int c = 4 * lane + 256 * j; const f32x4 gv = *(const f32x4*)(g + c), scv = *(const f32x4*)(sc + c), shv = *(const f32x4*)(sh + c);
            const f32x4 y = v[j] * r * gv * (scv + 1.0f) + shv;
            u32x2 w; w.x = pk_bf16(y.x, y.y); w.y = pk_bf16(y.z, y.w); *(u32x2*)(A + (size_t)row * D + c) = w; }
    }
}

__device__ __forceinline__ void head_nr64(int lane, bf16_t* hp, const u32x2 w1, const u32x2 w2, int sub, const float* __restrict__ g, bool rope, int t, const float* __restrict__ cs, const float* __restrict__ sn, float oscale, bool dostore) {
    float a[4] = {bflo(w1.x), bfhi(w1.x), bflo(w1.y), bfhi(w1.y)}, b[4] = {bflo(w2.x), bfhi(w2.x), bflo(w2.y), bfhi(w2.y)};
    float ss = 0.f;
#pragma unroll
    for (int e = 0; e < 4; ++e) ss += a[e] * a[e] + b[e] * b[e];
    ss += shx(ss, 1, lane); ss += shx(ss, 2, lane); ss += shx(ss, 4, lane);
    const float r = 1.0f / sqrtf(ss * (1.0f / 64.0f) + EPS);
    const f32x4 g1 = *(const f32x4*)(g + 4 * sub), g2 = *(const f32x4*)(g + 32 + 4 * sub);
#pragma unroll
    for (int e = 0; e < 4; ++e) { a[e] *= r * g1[e]; b[e] *= r * g2[e]; }
    if (rope) { const f32x4 c = *(const f32x4*)(cs + t * 32 + 4 * sub), s = *(const f32x4*)(sn + t * 32 + 4 * sub);
#pragma unroll
        for (int e = 0; e < 4; ++e) { const float na = a[e] * c[e] - b[e] * s[e], nb = a[e] * s[e] + b[e] * c[e]; a[e] = na; b[e] = nb; } }
#pragma unroll
    for (int e = 0; e < 4; ++e) { a[e] *= oscale; b[e] *= oscale; }
    if (dostore) { u32x2 o1, o2; o1.x = pk_bf16(a[0], a[1]); o1.y = pk_bf16(a[2], a[3]); o2.x = pk_bf16(b[0], b[1]); o2.y = pk_bf16(b[2], b[3]);
        *(u32x2*)(hp + 4 * sub) = o1; *(u32x2*)(hp + 32 + 4 * sub) = o2; }
}
__device__ __forceinline__ void head_nr96(int lane, const u32x4 wn, const unsigned wa, const unsigned wb, bf16_t* dst, int sub, const float* __restrict__ g, bool rope, int t, const float* __restrict__ cs, const float* __restrict__ sn, float oscale) {
    float n[8] = {bflo(wn.x), bfhi(wn.x), bflo(wn.y), bfhi(wn.y), bflo(wn.z), bfhi(wn.z), bflo(wn.w), bfhi(wn.w)};
    float a[2] = {bflo(wa), bfhi(wa)}, b[2] = {bflo(wb), bfhi(wb)};
    float ss = a[0] * a[0] + a[1] * a[1] + b[0] * b[0] + b[1] * b[1];
#pragma unroll
    for (int e = 0; e < 8; ++e) ss += n[e] * n[e];
    ss += shx(ss, 1, lane); ss += shx(ss, 2, lane); ss += shx(ss, 4, lane);
    const float r = 1.0f / sqrtf(ss * (1.0f / 96.0f) + EPS);
    const f32x4 ga = *(const f32x4*)(g + 8 * sub), gb = *(const f32x4*)(g + 8 * sub + 4);
#pragma unroll
    for (int e = 0; e < 4; ++e) { n[e] *= r * ga[e] * oscale; n[4 + e] *= r * gb[e] * oscale; }
#pragma unroll
    for (int e = 0; e < 2; ++e) { a[e] *= r * g[64 + 2 * sub + e]; b[e] *= r * g[80 + 2 * sub + e]; }
    if (rope) {
#pragma unroll
        for (int e = 0; e < 2; ++e) { const float c = cs[t * 16 + 2 * sub + e], s = sn[t * 16 + 2 * sub + e]; const float na = a[e] * c - b[e] * s, nb = a[e] * s + b[e] * c; a[e] = na; b[e] = nb; } }
    u32x4 o; o.x = pk_bf16(n[0], n[1]); o.y = pk_bf16(n[2], n[3]); o.z = pk_bf16(n[4], n[5]); o.w = pk_bf16(n[6], n[7]);
    *(u32x4*)(dst + 8 * sub) = o;
    *(unsigned*)(dst + 64 + 2 * sub) = pk_bf16(a[0] * oscale, a[1] * oscale); *(unsigned*)(dst + 80 + 2 * sub) = pk_bf16(b[0] * oscale, b[1] * oscale);
}

#define MFMA32(a, b, c) __builtin_amdgcn_mfma_f32_32x32x16_bf16((a), (b), (c), 0, 0, 0)
__device__ __forceinline__ int crow(int reg, int h) { return (reg & 3) + 8 * (reg >> 2) + 4 * h; }
__device__ __forceinline__ s16x4 vtr(const LAS unsigned char* p) { return __builtin_bit_cast(s16x4, __builtin_amdgcn_ds_read_tr16_b64_v4i16((LAS v4i16_t*)p)); }
__device__ __forceinline__ bf16x8 pack_step(const f32x16& x, int s) {
    u32x4 p; p.x = pk_bf16(x[8 * s + 0], x[8 * s + 1]); p.y = pk_bf16(x[8 * s + 2], x[8 * s + 3]); p.z = pk_bf16(x[8 * s + 4], x[8 * s + 5]); p.w = pk_bf16(x[8 * s + 6], x[8 * s + 7]);
    return __builtin_bit_cast(bf16x8, p);
}
template <int DQK, int DV, int KW, bool MASK>
__device__ __forceinline__ void attn_run(LAS unsigned char* lds, int tid, const bf16_t* __restrict__ Kg, int kpitch, const bf16_t* __restrict__ Vg, int vpitch,
                                         int ctx_row0, int lat_row0, int nt, const bf16x8 (&qf)[DQK / 16], int koffB, int qpos, int kpos0, bool late,
                                         f32x16 (&o)[DV / 32], float& m_out, float& l_out) {
    constexpr int KP = KW * 2 + 16, VP = DV * 2 + 64, KB = 64 * KP, VB = 64 * VP;
    constexpr int KCPR = KW / 8, VCPR = DV / 8, NKC = 64 * KCPR, NVC = 64 * VCPR, NKI = (NKC + 511) / 512, NVI = (NVC + 511) / 512;
    static_assert(2 * KB + 3 * VB <= 131072, "attention tiles fit");
    static_assert(NVC % 512 == 0, "V chunks");
    const int lane = tid & 63, r = lane & 31, h = lane >> 5;
    const int q4 = (lane & 15) >> 2, p4 = lane & 3, blk = (lane >> 4) & 1;
    unsigned vlane = (unsigned)((4 * h + q4) * VP + 32 * blk + 8 * p4), klane = (unsigned)(r * KP + koffB + h * 16); asm volatile("" : "+v"(vlane), "+v"(klane));
    unsigned kst[NKI], vst[NVI];
#pragma unroll
    for (int i_ = 0; i_ < NKI; ++i_) { const int c_ = tid + 512 * i_; kst[i_] = (unsigned)((c_ / KCPR) * KP + (c_ % KCPR) * 16); asm volatile("" : "+v"(kst[i_])); }
#pragma unroll
    for (int i_ = 0; i_ < NVI; ++i_) { const int c_ = tid + 512 * i_; vst[i_] = (unsigned)((c_ / VCPR) * VP + (c_ % VCPR) * 16); asm volatile("" : "+v"(vst[i_])); }
    u32x4 kregA[NKI], vregA[NVI];
#define ATT_GLOAD(t, KR, VR) do { const int tr_ = (t) < 4 ? ctx_row0 + 64 * (t) : lat_row0 + 64 * ((t) - 4); \
        _Pragma("unroll") for (int i_ = 0; i_ < NKI; ++i_) { const int c_ = tid + 512 * i_; if ((NKC % 512 == 0) || c_ < NKC) { const int rr_ = c_ / KCPR, cc_ = c_ % KCPR; KR[i_] = *(const u32x4*)(Kg + (size_t)(tr_ + rr_) * kpitch + cc_ * 8); } } \
        _Pragma("unroll") for (int i_ = 0; i_ < NVI; ++i_) { const int c_ = tid + 512 * i_; const int rr_ = c_ / VCPR, cc_ = c_ % VCPR; VR[i_] = *(const u32x4*)(Vg + (size_t)(tr_ + rr_) * vpitch + cc_ * 8); } } while (0)
#define ATT_LSTORE(kslot, vslot, KR, VR) do { LAS unsigned char* kb_ = lds + (kslot) * KB; LAS unsigned char* vb_ = lds + 2 * KB + (vslot) * VB; \
        _Pragma("unroll") for (int i_ = 0; i_ < NKI; ++i_) { const int c_ = tid + 512 * i_; if ((NKC % 512 == 0) || c_ < NKC) { *(LAS u32x4*)(kb_ + kst[i_]) = KR[i_]; } } \
        _Pragma("unroll") for (int i_ = 0; i_ < NVI; ++i_) { *(LAS u32x4*)(vb_ + vst[i_]) = VR[i_]; } } while (0)
#define ATT_SB() __builtin_amdgcn_sched_barrier(0)
#define ATT_BAR() do { asm volatile("s_waitcnt lgkmcnt(0)" ::: "memory"); __builtin_amdgcn_s_barrier(); asm volatile("" ::: "memory"); } while (0)
#define ATT_VLOAD(dst, vb_, c_) do { _Pragma("unroll") for (int e_ = 0; e_ < 2; ++e_) { const int g_ = (c_) / (DV / 64), db_ = 2 * ((c_) % (DV / 64)) + e_; \
            const LAS unsigned char* vp_ = (vb_) + ((32 * (g_ >> 1) + 16 * (g_ & 1)) * VP + 64 * db_); \
            const s16x4 lo_ = vtr(vp_), hi_ = vtr(vp_ + 8 * VP); dst[e_] = __builtin_shufflevector(lo_, hi_, 0, 1, 2, 3, 4, 5, 6, 7); } } while (0)
#define ATT_PVM(src, c_) do { _Pragma("unroll") for (int e_ = 0; e_ < 2; ++e_) { const int g_ = (c_) / (DV / 64), db_ = 2 * ((c_) % (DV / 64)) + e_; o[db_] = MFMA32(src[e_], pw[g_], o[db_]); } } while (0)
#define ATT_PV(vbase) do { const LAS unsigned char* vbp_ = (vbase); bf16x8 va_[2], vc_[2]; constexpr int NC_ = 4 * (DV / 64); \
        ATT_VLOAD(va_, vbp_, 0); ATT_SB(); \
        _Pragma("unroll") for (int c2_ = 0; c2_ < NC_; c2_ += 2) { \
            ATT_VLOAD(vc_, vbp_, c2_ + 1); ATT_SB(); ATT_PVM(va_, c2_); ATT_SB(); \
            if (c2_ + 2 < NC_) { ATT_VLOAD(va_, vbp_, c2_ + 2); } ATT_SB(); ATT_PVM(vc_, c2_ + 1); ATT_SB(); } } while (0)
    ATT_GLOAD(0, kregA, vregA); ATT_LSTORE(0, 0, kregA, vregA);
    ATT_BAR();
    float m = 0.f, l = 0.f; f32x16 negm; { float z_ = 0.f; asm volatile("" : "+v"(z_));
#pragma unroll
    for (int i = 0; i < 16; ++i) negm[i] = z_; }
    bf16x8 pw[4];
#pragma unroll
    for (int i = 0; i < 4; ++i) pw[i] = (bf16x8){0, 0, 0, 0, 0, 0, 0, 0};
    int vcur = 0, vprev = 0;
    for (int t2 = 0; t2 < nt; t2 += 2) {
#pragma unroll
    for (int par = 0; par < 2; ++par) { const int t = t2 + par; if (t < nt) {
        const int vnext = (vcur == 2) ? 0 : vcur + 1;
        if (t + 1 < nt) ATT_GLOAD(t + 1, kregA, vregA);
        const LAS unsigned char* kb = lds + (t & 1) * KB + klane;
        bf16x8 kf[2 * (DQK / 16)];
#pragma unroll
        for (int d0 = 0; d0 < DQK / 16; ++d0) {
            kf[2 * d0] = *(const LAS bf16x8*)(kb + d0 * 32);
            kf[2 * d0 + 1] = *(const LAS bf16x8*)(kb + 32 * KP + d0 * 32);
        }
        ATT_SB();
        if (late && t > 0) ATT_PV(lds + 2 * KB + vprev * VB + vlane);
        f32x16 s0 = negm, s1 = negm;
#pragma unroll
        for (int d0 = 0; d0 < DQK / 16; ++d0) { s0 = MFMA32(kf[2 * d0], qf[d0], s0); s1 = MFMA32(kf[2 * d0 + 1], qf[d0], s1); }
        ATT_SB();
        if (MASK) { if (t >= 4) { const int dq = kpos0 + 64 * (t - 4) - qpos;
#pragma unroll
            for (int i = 0; i < 16; ++i) { const int d0_ = dq + crow(i, h); if (d0_ > 128 || d0_ < -128) s0[i] = -INFINITY; const int d1_ = d0_ + 32; if (d1_ > 128 || d1_ < -128) s1[i] = -INFINITY; } } }
        float mt = __builtin_fmaxf(s0[0], s1[0]), mu = __builtin_fmaxf(s0[1], s1[1]);
#pragma unroll
        for (int i = 2; i < 16; i += 2) { mt = __builtin_fmaxf(__builtin_fmaxf(mt, s0[i]), s1[i]); mu = __builtin_fmaxf(__builtin_fmaxf(mu, s0[i + 1]), s1[i + 1]); }
        mt = __builtin_fmaxf(mt, mu);
        { auto rr = __builtin_amdgcn_permlane32_swap(__float_as_uint(mt), __float_as_uint(mt), false, false); mt = fmaxf(__uint_as_float(rr[0]), __uint_as_float(rr[1])); }
        constexpr float THR = 4.0f;
        if (t == 0 || __builtin_amdgcn_ballot_w64(mt > THR) != 0ull) {
            const float delta = (t == 0) ? mt : __builtin_fmaxf(mt, 0.f);
            if (t != 0) { const float alpha = __builtin_amdgcn_exp2f(-delta); l *= alpha;
#pragma unroll
                for (int db = 0; db < DV / 32; ++db)
#pragma unroll
                    for (int i = 0; i < 16; ++i) o[db][i] *= alpha; }
            m += delta;
#pragma unroll
            for (int i = 0; i < 16; ++i) { s0[i] -= delta; s1[i] -= delta; negm[i] = -m; }
            asm volatile("" : "+v"(negm));
        }
        float ps = 0.f;
#pragma unroll
        for (int i = 0; i < 16; ++i) { s0[i] = __builtin_amdgcn_exp2f(s0[i]); s1[i] = __builtin_amdgcn_exp2f(s1[i]); ps += s0[i] + s1[i]; }
        l += ps;
        pw[0] = pack_step(s0, 0); pw[1] = pack_step(s0, 1); pw[2] = pack_step(s1, 0); pw[3] = pack_step(s1, 1);
        if (!late) ATT_PV(lds + 2 * KB + vcur * VB + vlane);
        if (t + 1 < nt) ATT_LSTORE((t + 1) & 1, vnext, kregA, vregA);
        vprev = vcur; vcur = vnext;
        ATT_BAR();
    } } }
    if (late) ATT_PV(lds + 2 * KB + vprev * VB + vlane);
    ATT_BAR();
    m_out = m; l_out = l;
#undef ATT_GLOAD
#undef ATT_LSTORE
#undef ATT_PV
#undef ATT_PVM
#undef ATT_VLOAD
#undef ATT_SB
#undef ATT_BAR
}

template <int DQK, int DV, int KW, bool MASK>
__device__ __forceinline__ void attn_run2(LAS unsigned char* lds, int tid, const bf16_t* __restrict__ Kg, int kpitch, const bf16_t* __restrict__ Vg, int vpitch,
                                          int ctx_row0, int lat_row0, int nt, const bf16x8 (&qf)[DQK / 16], int koffB, int qpos, int kpos0,
                                          f32x16 (&o)[DV / 32], float& m_out, float& l_out) {
    constexpr int KP = KW * 2 + 16, VP = DV * 2 + 64, KB = 64 * KP, VB = 64 * VP, ND = DQK / 16;
    constexpr int KCPR = KW / 8, VCPR = DV / 8, NKC = 64 * KCPR, NVC = 64 * VCPR, NKI = (NKC + 511) / 512, NVI = (NVC + 511) / 512;
    static_assert(2 * KB + 3 * VB <= 131072 && NVC % 512 == 0 && ND % 2 == 0, "attention tiles");
    const int lane = tid & 63, r = lane & 31, h = lane >> 5;
    const int q4 = (lane & 15) >> 2, p4 = lane & 3, blk = (lane >> 4) & 1;
    u32x4 kregA[NKI], vregA[NVI], kregB[NKI], vregB[NVI];
#define A2_GLOAD(t, KR, VR) do { const int tr_ = (t) < 4 ? ctx_row0 + 64 * (t) : lat_row0 + 64 * ((t) - 4); \
        _Pragma("unroll") for (int i_ = 0; i_ < NKI; ++i_) { const int c_ = tid + 512 * i_; if ((NKC % 512 == 0) || c_ < NKC) { const int rr_ = c_ / KCPR, cc_ = c_ % KCPR; KR[i_] = *(const u32x4*)(Kg + (size_t)(tr_ + rr_) * kpitch + cc_ * 8); } } \
        _Pragma("unroll") for (int i_ = 0; i_ < NVI; ++i_) { const int c_ = tid + 512 * i_; const int rr_ = c_ / VCPR, cc_ = c_ % VCPR; VR[i_] = *(const u32x4*)(Vg + (size_t)(tr_ + rr_) * vpitch + cc_ * 8); } } while (0)
#define A2_LSTORE(kslot, vslot, KR, VR) do { LAS unsigned char* kb_ = lds + (kslot) * KB; LAS unsigned char* vb_ = lds + 2 * KB + (vslot) * VB; \
        _Pragma("unroll") for (int i_ = 0; i_ < NKI; ++i_) { const int c_ = tid + 512 * i_; if ((NKC % 512 == 0) || c_ < NKC) { const int rr_ = c_ / KCPR, cc_ = c_ % KCPR; *(LAS u32x4*)(kb_ + rr_ * KP + cc_ * 16) = KR[i_]; } } \
        _Pragma("unroll") for (int i_ = 0; i_ < NVI; ++i_) { const int c_ = tid + 512 * i_; const int rr_ = c_ / VCPR, cc_ = c_ % VCPR; *(LAS u32x4*)(vb_ + rr_ * VP + cc_ * 16) = VR[i_]; } } while (0)
#define A2_SB() __builtin_amdgcn_sched_barrier(0)
#define A2_KFRAG(kb_, d0_, half_) (*(const LAS bf16x8*)((kb_) + ((half_) * 32 + r) * KP + koffB + (d0_) * 32 + h * 16))
#define A2_EL(P0, P1, e_) (((e_) < 16) ? P0[(e_) & 15] : P1[(e_) & 15])
#define A2_FILLA(P0, P1, j_) do { if ((j_) < 8) { const int e_ = 4 * (j_); \
        sacc += (A2_EL(P0, P1, e_) + A2_EL(P0, P1, e_ + 1)) + (A2_EL(P0, P1, e_ + 2) + A2_EL(P0, P1, e_ + 3)); \
        pw[((j_) >> 2) * 2 + (((j_) & 3) >> 1)][2 * ((j_) & 1)] = pk_bf16(A2_EL(P0, P1, e_), A2_EL(P0, P1, e_ + 1)); \
        pw[((j_) >> 2) * 2 + (((j_) & 3) >> 1)][2 * ((j_) & 1) + 1] = pk_bf16(A2_EL(P0, P1, e_ + 2), A2_EL(P0, P1, e_ + 3)); } } while (0)
#define A2_QK(S0, S1, kb_, FILL, P0, P1) do { bf16x8 ka_[2], kc_[2]; \
        ka_[0] = A2_KFRAG(kb_, 0, 0); ka_[1] = A2_KFRAG(kb_, 0, 1); A2_SB(); \
        _Pragma("unroll") for (int d_ = 0; d_ < ND; d_ += 2) { \
            kc_[0] = A2_KFRAG(kb_, d_ + 1, 0); kc_[1] = A2_KFRAG(kb_, d_ + 1, 1); A2_SB(); \
            S0 = MFMA32(ka_[0], qf[d_], S0); if (FILL) A2_FILLA(P0, P1, 2 * d_); A2_SB(); \
            S1 = MFMA32(ka_[1], qf[d_], S1); if (FILL) A2_FILLA(P0, P1, 2 * d_ + 1); A2_SB(); \
            if (d_ + 2 < ND) { ka_[0] = A2_KFRAG(kb_, d_ + 2, 0); ka_[1] = A2_KFRAG(kb_, d_ + 2, 1); } A2_SB(); \
            S0 = MFMA32(kc_[0], qf[d_ + 1], S0); if (FILL) A2_FILLA(P0, P1, 2 * d_ + 2); A2_SB(); \
            S1 = MFMA32(kc_[1], qf[d_ + 1], S1); if (FILL) A2_FILLA(P0, P1, 2 * d_ + 3); A2_SB(); } } while (0)
#define A2_VLOAD(dst, vb_, c_) do { _Pragma("unroll") for (int e_ = 0; e_ < 2; ++e_) { const int g_ = (c_) / (DV / 64), db_ = 2 * ((c_) % (DV / 64)) + e_; \
            const LAS unsigned char* vp_ = (vb_) + (32 * (g_ >> 1) + 16 * (g_ & 1) + 4 * h + q4) * VP + (32 * db_ + 16 * blk) * 2 + 8 * p4; \
            const s16x4 lo_ = vtr(vp_), hi_ = vtr(vp_ + 8 * VP); dst[e_] = __builtin_shufflevector(lo_, hi_, 0, 1, 2, 3, 4, 5, 6, 7); } } while (0)
#define A2_FILLB(S0, S1, gap_) do { constexpr int EPG_ = 32 / (8 * (DV / 64)); _Pragma("unroll") for (int i_ = 0; i_ < EPG_; ++i_) { const int e_ = (gap_) * EPG_ + i_; \
        if (e_ < 16) S0[e_ & 15] = __builtin_amdgcn_exp2f(S0[e_ & 15] - m); else S1[e_ & 15] = __builtin_amdgcn_exp2f(S1[e_ & 15] - m); } } while (0)
#define A2_PVM1(src, c_, e_) do { const int g_ = (c_) / (DV / 64), db_ = 2 * ((c_) % (DV / 64)) + (e_); o[db_] = MFMA32(src[e_], __builtin_bit_cast(bf16x8, pw[g_]), o[db_]); } while (0)
#define A2_PV(vbase, S0, S1, DOEXP) do { const LAS unsigned char* vbp_ = (vbase); bf16x8 va_[2], vc_[2]; constexpr int NC_ = 4 * (DV / 64); \
        A2_VLOAD(va_, vbp_, 0); A2_SB(); \
        _Pragma("unroll") for (int c2_ = 0; c2_ < NC_; c2_ += 2) { \
            A2_VLOAD(vc_, vbp_, c2_ + 1); A2_SB(); \
            A2_PVM1(va_, c2_, 0); if (DOEXP) A2_FILLB(S0, S1, 2 * c2_); A2_SB(); \
            A2_PVM1(va_, c2_, 1); if (DOEXP) A2_FILLB(S0, S1, 2 * c2_ + 1); A2_SB(); \
            if (c2_ + 2 < NC_) { A2_VLOAD(va_, vbp_, c2_ + 2); } A2_SB(); \
            A2_PVM1(vc_, c2_ + 1, 0); if (DOEXP) A2_FILLB(S0, S1, 2 * c2_ + 2); A2_SB(); \
            A2_PVM1(vc_, c2_ + 1, 1); if (DOEXP) A2_FILLB(S0, S1, 2 * c2_ + 3); A2_SB(); } } while (0)
#define A2_ZERO(S0, S1) do { _Pragma("unroll") for (int i_ = 0; i_ < 16; ++i_) { S0[i_] = 0.f; S1[i_] = 0.f; } } while (0)
#define A2_MASK(S0, S1, t_) do { if (MASK) { if ((t_) >= 4) { const int dq_ = kpos0 + 64 * ((t_) - 4) - qpos; \
        _Pragma("unroll") for (int i_ = 0; i_ < 16; ++i_) { const int d0_ = dq_ + crow(i_, h); if (d0_ > 128 || d0_ < -128) S0[i_] = -INFINITY; const int d1_ = d0_ + 32; if (d1_ > 128 || d1_ < -128) S1[i_] = -INFINITY; } } } } while (0)
#define A2_ROWMAX(S0, S1, mt_) do { mt_ = fmaxf(S0[0], S1[0]); _Pragma("unroll") for (int i_ = 1; i_ < 16; ++i_) mt_ = fmaxf(mt_, fmaxf(S0[i_], S1[i_])); \
        auto rr_ = __builtin_amdgcn_permlane32_swap(__float_as_uint(mt_), __float_as_uint(mt_), false, false); mt_ = fmaxf(__uint_as_float(rr_[0]), __uint_as_float(rr_[1])); } while (0)
#define A2_BAR() do { asm volatile("s_waitcnt lgkmcnt(0)" ::: "memory"); __builtin_amdgcn_s_barrier(); asm volatile("" ::: "memory"); } while (0)
#define A2_STEP(t_, S0, S1, P0, P1, KRL, VRL, KRS, VRS) do { \
        const int vnext_ = (vcur == 2) ? 0 : vcur + 1; \
        if ((t_) + 2 < nt) A2_GLOAD((t_) + 2, KRL, VRL); \
        const LAS unsigned char* kbs_ = lds + ((t_) & 1) * KB; \
        float sacc = 0.f; A2_ZERO(S0, S1); \
        A2_QK(S0, S1, kbs_, true, P0, P1); \
        l += sacc; \
        A2_MASK(S0, S1, t_); \
        float mt_; A2_ROWMAX(S0, S1, mt_); \
        const float mn_ = fmaxf(m, mt_); const bool resc_ = __builtin_amdgcn_ballot_w64(mn_ > m) != 0ull; float alpha_ = 1.0f; \
        if (resc_) { alpha_ = __builtin_amdgcn_exp2f(m - mn_); l *= alpha_; m = mn_; } \
        A2_PV(lds + 2 * KB + vprev * VB, S0, S1, true); \
        if (resc_) { _Pragma("unroll") for (int db_ = 0; db_ < DV / 32; ++db_) _Pragma("unroll") for (int i_ = 0; i_ < 16; ++i_) o[db_][i_] *= alpha_; } \
        if ((t_) + 1 < nt) A2_LSTORE(((t_) + 1) & 1, vnext_, KRS, VRS); \
        vprev = vcur; vcur = vnext_; \
        A2_BAR(); } while (0)
    f32x16 sA0, sA1, sB0, sB1; u32x4 pw[4]; float m, l = 0.f;
    int vcur = 0, vprev = 0;
    A2_GLOAD(0, kregA, vregA); A2_LSTORE(0, 0, kregA, vregA);
    if (1 < nt) A2_GLOAD(1, kregB, vregB);
    A2_BAR();
    {
        if (2 < nt) A2_GLOAD(2, kregA, vregA);
        A2_ZERO(sA0, sA1); float sacc = 0.f;
        A2_QK(sA0, sA1, lds, false, sA0, sA1); (void)sacc;
        A2_MASK(sA0, sA1, 0);
        float mt_; A2_ROWMAX(sA0, sA1, mt_); m = mt_;
#pragma unroll
        for (int i = 0; i < 16; ++i) { sA0[i] = __builtin_amdgcn_exp2f(sA0[i] - m); sA1[i] = __builtin_amdgcn_exp2f(sA1[i] - m); }
        if (1 < nt) A2_LSTORE(1, 1, kregB, vregB);
        vprev = 0; vcur = 1;
        A2_BAR();
    }
    for (int t2 = 1; t2 < nt; t2 += 2) {
        A2_STEP(t2, sB0, sB1, sA0, sA1, kregB, vregB, kregA, vregA);
        if (t2 + 1 < nt) A2_STEP(t2 + 1, sA0, sA1, sB0, sB1, kregA, vregA, kregB, vregB);
    }
    {
        float sacc = 0.f;
        if ((nt - 1) & 1) {
#pragma unroll
            for (int j = 0; j < 8; ++j) A2_FILLA(sB0, sB1, j);
        } else {
#pragma unroll
            for (int j = 0; j < 8; ++j) A2_FILLA(sA0, sA1, j);
        }
        l += sacc;
        A2_PV(lds + 2 * KB + vprev * VB, sA0, sA1, false);
    }
    __syncthreads();
    m_out = m; l_out = l;
#undef A2_GLOAD
#undef A2_LSTORE
#undef A2_SB
#undef A2_KFRAG
#undef A2_EL
#undef A2_FILLA
#undef A2_QK
#undef A2_VLOAD
#undef A2_FILLB
#undef A2_PVM1
#undef A2_PV
#undef A2_ZERO
#undef A2_MASK
#undef A2_ROWMAX
#undef A2_STEP
#undef A2_BAR
}
template <int NDB>
__device__ __forceinline__ void write_o(int lane, const f32x16 (&o)[NDB], float l, float m, bool sink, float sinkv, bf16_t* obase, int hh, LAS unsigned char* stg) {
    float lt = l + shx(l, 32, lane); if (sink) lt += __builtin_amdgcn_exp2f(sinkv - m);
    const float inv = 1.0f / lt;
    constexpr int RB = NDB * 64 + 16, CPR = NDB * 4;
    LAS unsigned char* wp = stg + (lane & 31) * RB + 8 * hh;
#pragma unroll
    for (int db = 0; db < NDB; ++db)
#pragma unroll
        for (int g = 0; g < 4; ++g) { u32x2 w; w.x = pk_bf16(o[db][4 * g] * inv, o[db][4 * g + 1] * inv); w.y = pk_bf16(o[db][4 * g + 2] * inv, o[db][4 * g + 3] * inv);
            *(LAS u32x2*)(wp + 64 * db + 16 * g) = w; }
    asm volatile("s_waitcnt lgkmcnt(0)" ::: "memory");
#pragma unroll
    for (int i = 0; i < 32 * CPR / 64; ++i) { const int c = i * 64 + lane, row = c / CPR, ch = c % CPR;
        const u32x4 v = *(const LAS u32x4*)(stg + row * RB + ch * 16); *(u32x4*)(obase + (size_t)row * 1024 + ch * 8) = v; }
    asm volatile("s_waitcnt lgkmcnt(0)" ::: "memory");
}

#define XB_TMO      128
#define XB_XCNT(j)  (256  + 64 * (j))
#define XB_XSUB(j)  (1280 + 64 * (j))
#define XB_XGEN(j)  (2304 + 64 * (j))
#define XB_TOP      3328
#define XB_TOPGEN   3392
#define XCD_BAR_WORDS 3456
#define XB_SPIN_CAP (1u << 18)
__device__ __forceinline__ unsigned xb_ld(unsigned* p)              { return __hip_atomic_load(p, __ATOMIC_RELAXED, __HIP_MEMORY_SCOPE_AGENT); }
__device__ __forceinline__ unsigned xb_add(unsigned* p, unsigned v) { return __hip_atomic_fetch_add(p, v, __ATOMIC_RELAXED, __HIP_MEMORY_SCOPE_AGENT); }
__device__ __forceinline__ unsigned xb_xcc_id() { return (unsigned)__builtin_amdgcn_s_getreg((3 << 11) | 20) & 0xFu; }
#define XB_SPIN(cond, bar) do { unsigned _sp = 0; while (cond) { __builtin_amdgcn_s_sleep(1); \
    if ((++_sp & 255u) == 0u) { if (xb_ld(&(bar)[XB_TMO])) break; if (_sp > XB_SPIN_CAP) { atomicAdd(&(bar)[XB_TMO], 1u); break; } } } } while (0)
__device__ __forceinline__ void xcd_barrier_complete(unsigned* bar, unsigned x, unsigned& nloc, unsigned& nx) {
    const unsigned G = gridDim.x * gridDim.y * gridDim.z;
    unsigned sum, cnt, mine, sp = 0u;
    for (;;) {
        sum = 0u; cnt = 0u; mine = 0u;
#pragma unroll
        for (unsigned j = 0; j < 16; ++j) { const unsigned c = xb_ld(&bar[XB_XCNT(j)]); sum += c; cnt += (c > 0u) ? 1u : 0u; mine = (j == x) ? c : mine; }
        if (sum == G) break;
        __builtin_amdgcn_s_sleep(1);
        if ((++sp & 255u) == 0u) { if (xb_ld(&bar[XB_TMO])) break; if (sp > XB_SPIN_CAP) { atomicAdd(&bar[XB_TMO], 1u); break; } }
    }
    nloc = mine > 0u ? mine : 1u; nx = cnt > 0u ? cnt : 1u;
}
__device__ __forceinline__ void xcd_barrier(unsigned* bar, volatile LAS unsigned* st, int tid) {
    asm volatile("s_waitcnt vmcnt(0)" ::: "memory");
    __syncthreads();
    if (tid == 0) {
        const unsigned x = xb_xcc_id();
        __builtin_amdgcn_s_waitcnt(0);
        unsigned nloc = st[0], nx = st[1];
        if (nloc == 0u) { xcd_barrier_complete(bar, x, nloc, nx); st[0] = nloc; st[1] = nx; }
        const unsigned old = xb_add(&bar[XB_XSUB(x)], 1u);
        const unsigned gen = old / nloc;
        if (old + 1u == (gen + 1u) * nloc) {
            __builtin_amdgcn_fence(__ATOMIC_RELEASE, "agent");
            asm volatile("s_waitcnt vmcnt(0)" ::: "memory");
            const unsigned og = xb_add(&bar[XB_TOP], 1u);
            const unsigned tg = og / nx;
            if (og + 1u == (tg + 1u) * nx) xb_add(&bar[XB_TOPGEN], 1u);
            else XB_SPIN(xb_ld(&bar[XB_TOPGEN]) == tg, bar);
            __builtin_amdgcn_fence(__ATOMIC_ACQUIRE, "agent");
            xb_add(&bar[XB_XGEN(x)], 1u);
            asm volatile("s_waitcnt vmcnt(0)" ::: "memory");
        } else {
            XB_SPIN(xb_ld(&bar[XB_XGEN(x)]) == gen, bar);
            __builtin_amdgcn_fence(__ATOMIC_ACQUIRE, "agent");
            asm volatile("s_waitcnt vmcnt(0)" ::: "memory");
        }
    }
    __syncthreads();
}

struct Args { const float* in[36]; float* out; unsigned char* ws; };

__global__ void __launch_bounds__(512) fwd_megakernel(Args a) {
    extern __shared__ __attribute__((aligned(16))) unsigned char lds_raw[];
    asm volatile("s_nop 0");
    LAS unsigned char* lds = (LAS unsigned char*)lds_raw;
    const int wave0 = __builtin_amdgcn_readfirstlane((int)threadIdx.x >> 6);
    typedef const __attribute__((address_space(4))) unsigned char* kptr_t;
    const int G = gridDim.x, bid = blockIdx.x, NGW = G * 8;
#define PHASE_IDS() int tid; asm volatile("v_mbcnt_lo_u32_b32 %0, -1, 0\n\tv_mbcnt_hi_u32_b32 %0, -1, %0" : "=v"(tid)); tid += wave0 * 64; const int lane = tid & 63; const int wave = __builtin_amdgcn_readfirstlane(tid >> 6); const int gw = bid * 8 + wave; (void)lane; (void)wave; (void)gw; \
    kptr_t ka_ = (kptr_t)__builtin_amdgcn_kernarg_segment_ptr(); asm volatile("" : "+s"(ka_)); \
    unsigned char* ws = *(unsigned char* const __attribute__((address_space(4)))*)(ka_ + 37 * 8); float* OUT = *(float* const __attribute__((address_space(4)))*)(ka_ + 36 * 8); \
    float* modtab = (float*)(ws + WS_MOD); float* cos64 = (float*)(ws + WS_ROPE); float* sin64 = cos64 + 2048 * 32; float* cos32 = sin64 + 2048 * 32; float* sin32 = cos32 + 2048 * 16; \
    float* HC = (float*)(ws + WS_HC); bf16_t* W = (bf16_t*)(ws + WS_W); bf16_t* A = (bf16_t*)OUT; _Float16* HL = (_Float16*)(ws + WS_HL); _Float16* HCh = (_Float16*)(ws + WS_HCH); (void)HL; (void)HCh; bf16_t* U = (bf16_t*)(ws + WS_P); bf16_t* P1 = U; bf16_t* P0 = U; \
    bf16_t* Qf = (bf16_t*)(ws + WS_QF); bf16_t* KVf = (bf16_t*)(ws + WS_KVF); bf16_t* MK = (bf16_t*)(ws + WS_MK); \
    const float* modl = modtab + (size_t)l * 17 * 9216; const float* ng = l ? IN(23) : IN(6); \
    (void)modtab; (void)cos64; (void)sin64; (void)cos32; (void)sin32; (void)HC; (void)W; (void)A; (void)U; (void)P1; (void)P0; (void)Qf; (void)KVf; (void)MK; (void)OUT; (void)modl; (void)ng
#define IN(i) (*(const float* const __attribute__((address_space(4)))*)(ka_ + 8 * (i)))
#define PHASE_IDS0() const int l = 0; PHASE_IDS()
#define GRID_BAR() do { int tb_; asm volatile("v_mbcnt_lo_u32_b32 %0, -1, 0\n\tv_mbcnt_hi_u32_b32 %0, -1, %0" : "=v"(tb_)); tb_ += wave0 * 64; \
    kptr_t kb_ = (kptr_t)__builtin_amdgcn_kernarg_segment_ptr(); asm volatile("" : "+s"(kb_)); unsigned char* wsb_ = *(unsigned char* const __attribute__((address_space(4)))*)(kb_ + 37 * 8); \
    xcd_barrier((unsigned*)(wsb_ + WS_BAR), (volatile LAS unsigned*)(lds + 131072 + 512), tb_); } while (0)

    {
        const int l = 0; PHASE_IDS();
        if (tid < 2) ((volatile LAS unsigned*)(lds + 131072 + 512))[tid] = 0u;
        if (bid == 0) { unsigned* bar = (unsigned*)(ws + WS_BAR); for (int i = tid; i < XCD_BAR_WORDS; i += 512) __hip_atomic_store(&bar[i], 0u, __ATOMIC_RELAXED, __HIP_MEMORY_SCOPE_AGENT); }
        for (int i = bid * 512 + tid; i < 2048 * 32 + 2048 * 16; i += G * 512) {
            if (i < 2048 * 32) { const int t = i >> 5, f = i & 31; const float inv = exp2f(-(float)(f & 15) * (13.287712379549449f / 16.0f)); const float pos = (f < 16) ? (float)(t >> 6) : (float)(t & 63);
                const float ang = pos * inv; float sn, cs; sincos_d((double)ang, sn, cs); cos64[i] = cs; sin64[i] = sn; }
            else { const int j = i - 2048 * 32; const int t = j >> 4, f = j & 15; const float inv = exp2f(-(float)(f & 7) * (13.287712379549449f / 8.0f)); const float pos = (f < 8) ? (float)(t >> 6) : (float)(t & 63);
                const float ang = pos * inv; float sn, cs; sincos_d((double)ang, sn, cs); cos32[j] = cs; sin32[j] = sn; }
        }
        for (int i = bid * 512 + tid; i < 96 * 1024 / 8; i += G * 512) *(u32x4*)(W + WO_WIN0 + (size_t)1184 * 1024 + (size_t)i * 8) = (u32x4){0u, 0u, 0u, 0u};
        if (bid < 288) {
            LAS float* sc = (LAS float*)lds;
            LAS float* part = sc + 17 * 1024;
            for (int i = tid; i < 17 * 1024; i += 512) { const float v = i < 16 * 1024 ? IN(1)[i] : IN(3)[i - 16 * 1024]; sc[i] = v / (1.0f + expf(-v)); }
            __syncthreads();
            for (int task = bid; task < 288; task += G) {
                const int l = task / 144, gq = task % 144, j = gq * 64 + lane;
                const float* aw = l ? IN(21) : IN(4); const float* ab = l ? IN(22) : IN(5);
                float acc[17];
#pragma unroll
                for (int b = 0; b < 17; ++b) acc[b] = 0.f;
                const int kbeg = wave * 128;
#pragma unroll 4
                for (int k = kbeg; k < kbeg + 128; ++k) { const float w = aw[(size_t)k * 9216 + j];
#pragma unroll
                    for (int b = 0; b < 17; ++b) acc[b] += sc[b * 1024 + k] * w; }
#pragma unroll
                for (int b = 0; b < 17; ++b) part[(wave * 17 + b) * 64 + lane] = acc[b];
                __syncthreads();
                for (int o = tid; o < 17 * 64; o += 512) { const int b = o >> 6, ln = o & 63; float s = 0.f;
#pragma unroll
                    for (int w = 0; w < 8; ++w) s += part[(w * 17 + b) * 64 + ln];
                    modtab[(size_t)(l * 17 + b) * 9216 + gq * 64 + ln] = s + ab[gq * 64 + ln]; }
                __syncthreads();
            }
        }
        __syncthreads();
        LAS float* scr = (LAS float*)(lds + wave * 16384);
        constexpr int IT_G = 16 * 88, IT_D = 44 * 32, IT_WIN0 = 16 * 37, IT_WQB = 4 * 24, IT_WKVB = 2 * 32, IT_WOUT = 16 * 32, IT_WIN1 = 16 * 96;
        constexpr int NITEMS = 8 * IT_G + 4 * IT_D + IT_WIN0 + IT_WQB + IT_WKVB + 2 * IT_WOUT + IT_WIN1;
        for (int it = gw; it < NITEMS; it += NGW) {
            int r = it;
            if (r < 8 * IT_G) { const int mi = r / IT_G; r -= mi * IT_G; const int l = mi >> 2, s = (mi >> 1) & 1, gu = mi & 1;
                const float* src = (l ? (gu ? IN(25) : IN(24)) : (gu ? IN(8) : IN(7))) + (size_t)s * 1024 * 2816;
                conv_item(src, 1024, 2816, W + WO_GU + (size_t)(l * 2 + s) * SZ_GU, 1 + gu, scr, r, lane); continue; }
            r -= 8 * IT_G;
            if (r < 4 * IT_D) { const int mi = r / IT_D; r -= mi * IT_D; const int l = mi >> 1, s = mi & 1;
                const float* src = (l ? IN(26) : IN(9)) + (size_t)s * 2816 * 1024;
                conv_item(src, 2816, 1024, W + WO_WD + (size_t)(l * 2 + s) * SZ_WD, 0, scr, r, lane); continue; }
            r -= 4 * IT_D;
            if (r < IT_WIN0) { conv_item(IN(10), 1024, 1184, W + WO_WIN0, 0, scr, r, lane); continue; } r -= IT_WIN0;
            if (r < IT_WQB) { conv_item(IN(12), 256, 768, W + WO_WQB, 0, scr, r, lane); continue; } r -= IT_WQB;
            if (r < IT_WKVB) { conv_item(IN(14), 128, 1024, W + WO_WKVB, 0, scr, r, lane); continue; } r -= IT_WKVB;
            if (r < IT_WOUT) { conv_item(IN(20), 1024, 1024, W + WO_WOUT0, 0, scr, r, lane); continue; } r -= IT_WOUT;
            if (r < IT_WIN1) { conv_item(IN(27), 1024, 3072, W + WO_WIN1, 3, scr, r, lane); continue; } r -= IT_WIN1;
            conv_item(IN(35), 1024, 1024, W + WO_WOUT1, 0, scr, r, lane);
        }
    }
    cg::this_grid().sync();
    { PHASE_IDS0(); if (tid == 0) (void)xb_add((unsigned*)(ws + WS_BAR) + XB_XCNT(xb_xcc_id()), 1u); }

#pragma nounroll
    for (int step = 0; step < 4; ++step) {
        const int l = step >> 1, s = step & 1;

        if (s == 1) {
            { PHASE_IDS(); norm_phase(HL, true, l ? (const void*)HCh : (const void*)IN(2), l != 0, MT, ng + 1024, modl, 1, A, gw, NGW, lane, (const _Float16*)(ws + WS_PART), HCh); }
            GRID_BAR();
            if (l == 0) {   PHASE_IDS();
                pg8::Gemm g{A, W + WO_WIN0, MT, P0W, 1024, 1024}; pg8::StaticOrder S; S.init(MT, P0W, G, bid);
                pg8::EpiStoreBf16 E{P0, P0P};
                pg8::gemm_phase<pg8::EpiStoreBf16, pg8::StaticOrder, true, true>(lds, g, S, E, tid);
            } else {        PHASE_IDS();
                pg8::Gemm g{A, W + WO_WIN1, MT, P1W, 1024, 1024}; pg8::StaticOrder S; S.init(MT, P1W, G, bid);
                pg8::EpiQKV1 E{P1, P1P, IN(28), IN(29), cos64, sin64, ML / 256, 0.125f * LOG2E, EPS};
                pg8::gemm_phase<pg8::EpiQKV1, pg8::StaticOrder, true, true>(lds, g, S, E, tid);
            }
            GRID_BAR();
            if (l == 0) {
                { PHASE_IDS();
                for (int row = gw; row < MT; row += NGW) {
                    bf16_t* p = P0 + (size_t)row * P0P; const bool lat = row < ML; const int t = row & 2047; const int sub = lane & 7;
                    bf16_t* hq = p + 416 + (lane >> 3) * 64; bf16_t* hk = p + 928 + ((lane >> 3) & 1) * 64;
                    const u32x2 w = *(const u32x2*)(p + 4 * lane); const unsigned wv = *(const unsigned*)(p + 256 + 2 * lane);
                    const u32x2 q1 = *(const u32x2*)(hq + 4 * sub), q2 = *(const u32x2*)(hq + 32 + 4 * sub), k1 = *(const u32x2*)(hk + 4 * sub), k2 = *(const u32x2*)(hk + 32 + 4 * sub);
                    { const float x0 = bflo(w.x), x1 = bfhi(w.x), x2 = bflo(w.y), x3 = bfhi(w.y);
                      const float ss = wave_sum((x0 * x0 + x1 * x1) + (x2 * x2 + x3 * x3), lane); const float r = 1.0f / sqrtf(ss * (1.0f / 256.0f) + EPS); const f32x4 gq = *(const f32x4*)(IN(11) + 4 * lane);
                      u32x2 o; o.x = pk_bf16(x0 * r * gq.x, x1 * r * gq.y); o.y = pk_bf16(x2 * r * gq.z, x3 * r * gq.w); *(u32x2*)(p + 4 * lane) = o; }
                    { const float x0 = bflo(wv), x1 = bfhi(wv);
                      const float ss = wave_sum(x0 * x0 + x1 * x1, lane); const float r = 1.0f / sqrtf(ss * (1.0f / 128.0f) + EPS);
                      *(unsigned*)(p + 256 + 2 * lane) = pk_bf16(x0 * r * IN(13)[2 * lane], x1 * r * IN(13)[2 * lane + 1]); }
                    head_nr64(lane, hq, q1, q2, sub, IN(17), lat, t, cos64, sin64, 0.125f * LOG2E, true);
                    head_nr64(lane, hk, k1, k2, sub, IN(18), lat, t, cos64, sin64, 1.0f, lane < 16);
                } }
                GRID_BAR();
                {   PHASE_IDS(); pg8::Gemm g{P0, W + WO_WQB, MT, 768, 256, P0P}; pg8::StaticOrder S; S.init(MT, 768, G, bid);
                    pg8::EpiStoreBf16 E{Qf, 768};
                    pg8::gemm_phase<pg8::EpiStoreBf16, pg8::StaticOrder, true, true>(lds, g, S, E, tid); }
                {   PHASE_IDS(); pg8::Gemm g{P0 + 256, W + WO_WKVB, MT, 1024, 128, P0P}; pg8::StaticOrder S; S.init(MT, 1024, G, bid);
                    pg8::EpiStoreBf16 E{KVf, KVP};
                    pg8::gemm_phase<pg8::EpiStoreBf16, pg8::StaticOrder, true, true>(lds, g, S, E, tid); }
                GRID_BAR();
                { PHASE_IDS();
                for (int row = gw; row < MT; row += NGW) {
                    const bool lat = row < ML; const int t = row & 2047; const int hd = lane >> 3, sub = lane & 7;
                    bf16_t* qp = Qf + (size_t)row * 768 + hd * 96; const bf16_t* kvp = KVf + (size_t)row * KVP + hd * 128; const bf16_t* krp = P0 + (size_t)row * P0P + 384;
                    const u32x4 wnq = *(const u32x4*)(qp + 8 * sub); const unsigned waq = *(const unsigned*)(qp + 64 + 2 * sub), wbq = *(const unsigned*)(qp + 80 + 2 * sub);
                    const u32x4 wnk = *(const u32x4*)(kvp + 8 * sub); const unsigned wak = *(const unsigned*)(krp + 2 * sub), wbk = *(const unsigned*)(krp + 16 + 2 * sub);
                    head_nr96(lane, wnq, waq, wbq, qp, sub, IN(15), lat, t, cos32, sin32, 0.10206207261596575f * LOG2E);
                    head_nr96(lane, wnk, wak, wbk, MK + (size_t)row * MKP + hd * 96, sub, IN(16), lat, t, cos32, sin32, 1.0f);
                } }
                GRID_BAR();
                { PHASE_IDS();
                for (int rep_ = 0; rep_ < REP_ATT0; ++rep_)
                for (int u = ((G & 7) == 0 ? (bid & 7) * (G >> 3) + (bid >> 3) : bid); u < 1024 + 128 + 1152; u += G) {

                    const int r = lane & 31, hh = lane >> 5;
                    if (u < 1024 + 128) {
                        int b, h, qrow0, nt;
                        if (u < 1024) { b = u >> 6; h = (u >> 3) & 7; qrow0 = b * 2048 + 256 * (u & 7); nt = 36; }
                        else { const int v = u - 1024; b = v >> 3; h = v & 7; qrow0 = ML + b * 256; nt = 4; }
                        const int qrow = qrow0 + 32 * wave + r;
                        bf16x8 qf[6];
#pragma unroll
                        for (int d0 = 0; d0 < 6; ++d0) qf[d0] = *(const bf16x8*)(Qf + (size_t)qrow * 768 + h * 96 + 16 * d0 + 8 * hh);
                        f32x16 o[2];
#pragma unroll
                        for (int i = 0; i < 16; ++i) { o[0][i] = 0.f; o[1][i] = 0.f; }
                        float m, lsum;
                        attn_run<96, 64, 96, false>(lds, tid, MK + h * 96, MKP, KVf + h * 128 + 64, KVP, ML + b * 256, b * 2048, nt, qf, 0, 0, 0, false, o, m, lsum);
                        write_o<2>(lane, o, lsum, m, false, 0.f, A + (size_t)(qrow - r) * 1024 + h * 64, hh, lds + 65536 + wave * 4608);
                    } else {
                        const int v = u - 1152; const int b = v / 72, kvh = (v / 36) & 1, qb = v % 36;
                        const bool isctx = qb < 4; const int q0l = isctx ? 0 : 64 * (qb - 4);
                        const int hq = kvh * 4 + (wave >> 1), qloc = 32 * (wave & 1) + r;
                        const int qrow = (isctx ? ML + b * 256 + 64 * qb : b * 2048 + q0l) + qloc;
                        int lat0 = 0, nt = 4;
                        if (!isctx) { lat0 = q0l - 128 > 0 ? q0l - 128 : 0; const int last = q0l + 192 < 2048 ? q0l + 192 : 2048; nt = 4 + (last - lat0) / 64; }
                        bf16x8 qf[4];
#pragma unroll
                        for (int d0 = 0; d0 < 4; ++d0) qf[d0] = *(const bf16x8*)(P0 + (size_t)qrow * P0P + 416 + hq * 64 + 16 * d0 + 8 * hh);
                        f32x16 o[2];
#pragma unroll
                        for (int i = 0; i < 16; ++i) { o[0][i] = 0.f; o[1][i] = 0.f; }
                        float m, lsum;
                        attn_run<64, 64, 64, true>(lds, tid, P0 + 928 + kvh * 64, P0P, P0 + 1056 + kvh * 64, P0P, ML + b * 256, b * 2048 + lat0, nt, qf, 0, q0l + qloc, lat0, false, o, m, lsum);
                        write_o<2>(lane, o, lsum, m, true, IN(19)[hq] * LOG2E, A + (size_t)(qrow - r) * 1024 + 512 + hq * 64, hh, lds + 65536 + wave * 4608);
                    }
                } }
            } else {
                { PHASE_IDS();
                const float lam = __expf(wave_sum(IN(30)[lane] * IN(31)[lane], lane)) - __expf(wave_sum(IN(32)[lane] * IN(33)[lane], lane)) + LAMBDA_INIT;
                for (int rep_ = 0; rep_ < REP_ATT1; ++rep_)
                for (int u = ((G & 7) == 0 ? (bid & 7) * (G >> 3) + (bid >> 3) : bid); u < 2048; u += G) {

                    const int r = lane & 31, hh = lane >> 5;
                    const int b = u >> 7, h = (u >> 4) & 7, qb = u & 15, mm = wave >> 2;
                    const int qrow = b * 2048 + 128 * qb + 32 * (wave & 3) + r;
                    bf16x8 qf[4];
#pragma unroll
                    for (int d0 = 0; d0 < 4; ++d0) qf[d0] = *(const bf16x8*)(P1 + (size_t)qrow * P1P + h * 128 + mm * 64 + 16 * d0 + 8 * hh);
                    f32x16 o[4];
#pragma unroll
                    for (int db = 0; db < 4; ++db)
#pragma unroll
                        for (int i = 0; i < 16; ++i) o[db][i] = 0.f;
                    float m, lsum;
                    attn_run<64, 128, 128, false>(lds, tid, P1 + 1024 + h * 128, P1P, P1 + 2048 + h * 128, P1P, ML + b * 256, b * 2048, 36, qf, mm * 128, 0, 0, false, o, m, lsum);
                    const float inv = 1.0f / (lsum + shx(lsum, 32, lane));
                    LAS float* stage = (LAS float*)lds + ((wave & 3) * 64) * 64 + lane;
                    asm volatile("" : "+v"(stage));
                    if (mm == 1) {
#pragma unroll
                        for (int db = 0; db < 4; ++db)
#pragma unroll
                            for (int i = 0; i < 16; ++i) stage[(db * 16 + i) * 64] = o[db][i] * inv;
                    }
                    __syncthreads();
                    if (mm == 0) {
                        float ss = 0.f;
#pragma unroll
                        for (int db = 0; db < 4; ++db)
#pragma unroll
                            for (int i = 0; i < 16; ++i) { const float x = o[db][i] * inv - lam * stage[(db * 16 + i) * 64]; o[db][i] = x; ss += x * x; }
                        ss += shx(ss, 32, lane);
                        const float rr = (1.0f - LAMBDA_INIT) / sqrtf(ss * (1.0f / 128.0f) + EPS);
                        LAS unsigned char* stg = lds + 96256 + wave * 8704;
                        LAS unsigned char* wp = stg + r * 272 + 8 * hh;
#pragma unroll
                        for (int db = 0; db < 4; ++db)
#pragma unroll
                            for (int g4 = 0; g4 < 4; ++g4) { const int d = 32 * db + 8 * g4 + 4 * hh; const f32x4 sg = *(const f32x4*)(IN(34) + d);
                                u32x2 w; w.x = pk_bf16(o[db][4 * g4] * rr * sg.x, o[db][4 * g4 + 1] * rr * sg.y); w.y = pk_bf16(o[db][4 * g4 + 2] * rr * sg.z, o[db][4 * g4 + 3] * rr * sg.w);
                                *(LAS u32x2*)(wp + 64 * db + 16 * g4) = w; }
                        asm volatile("s_waitcnt lgkmcnt(0)" ::: "memory");
                        bf16_t* obase = A + (size_t)(qrow - r) * 1024 + h * 128;
#pragma unroll
                        for (int i = 0; i < 8; ++i) { const int c = i * 64 + lane, row = c >> 4, ch = c & 15;
                            const u32x4 v = *(const LAS u32x4*)(stg + row * 272 + ch * 16); *(u32x4*)(obase + (size_t)row * 1024 + ch * 8) = v; }
                        asm volatile("s_waitcnt lgkmcnt(0)" ::: "memory");
                    }
                    __syncthreads();
                } }
            }
            GRID_BAR();
            {   PHASE_IDS();
                const int M = l ? ML : MT;
                pg8::Gemm g{A, W + (l ? WO_WOUT1 : WO_WOUT0), M, 1024, 1024, 1024}; pg8::SplitCtxOrder S; S.init(ML, 1024, G, bid, 16, l == 0);
                pg8::EpiResidPart<true, true> E{HL, HL, (_Float16*)(ws + WS_PART), modl + 5 * 1024, 1.0f, ML / 256};
                pg8::gemm_phase<pg8::EpiResidPart<true, true>, pg8::SplitCtxOrder, true, true>(lds, g, S, E, tid);
            }
            GRID_BAR();
        }
        const int Mf = (step == 3) ? ML : MT;
        {
#define NLNC() const void* nl = (step == 0) ? (const void*)IN(0) : (const void*)HL; const void* nc = (step == 0) ? (const void*)IN(2) : (const void*)HCh
            for (int rep_ = 0; rep_ < REP_NORM; ++rep_) { PHASE_IDS(); NLNC(); norm_phase(nl, step != 0, nc, step != 0, Mf, ng + (s ? 2048 : 0), modl, s ? 2 : 0, A, gw, NGW, lane, (step == 1 || step == 2) ? (const _Float16*)(ws + WS_PART) : (const _Float16*)nullptr, HCh); }
            GRID_BAR();
            {   PHASE_IDS(); pg8::Gemm g{A, W + WO_GU + (size_t)step * SZ_GU, Mf, 5632, 1024, 1024}; pg8::StaticOrder S; S.init(Mf, 5632, G, bid);
                pg8::EpiSwiglu E{U, DFF};
                for (int rep_ = 0; rep_ < REP_GU; ++rep_) pg8::gemm_phase<pg8::EpiSwiglu, pg8::StaticOrder, true, true>(lds, g, S, E, tid); }
            GRID_BAR();
            {   PHASE_IDS(); NLNC(); pg8::Gemm g{U, W + WO_WD + (size_t)step * SZ_WD, Mf, 1024, DFF, DFF}; pg8::SplitCtxOrder S; S.init(ML, 1024, G, bid, DFF / 64, step < 3);
                (void)nc; _Float16* partp = (_Float16*)(ws + WS_PART); const float* gatep = modl + (s ? 8 : 2) * 1024;
                if (step == 0) { pg8::EpiResidPart<false, true> E{nl, HL, partp, gatep, 0.5f, ML / 256}; pg8::gemm_phase<pg8::EpiResidPart<false, true>, pg8::SplitCtxOrder, true, true>(lds, g, S, E, tid); }
                else if (step == 3) { pg8::EpiResidPart<true, false> E{nl, OUT, partp, gatep, 0.5f, ML / 256}; pg8::gemm_phase<pg8::EpiResidPart<true, false>, pg8::SplitCtxOrder, true, true>(lds, g, S, E, tid); }
                else { pg8::EpiResidPart<true, true> E{nl, HL, partp, gatep, 0.5f, ML / 256}; pg8::gemm_phase<pg8::EpiResidPart<true, true>, pg8::SplitCtxOrder, true, true>(lds, g, S, E, tid); } }
            if (step < 3) GRID_BAR();
            for (int rep_ = 0; rep_ < REP_SYNC; ++rep_) GRID_BAR();
        }
    }
#undef IN
}

extern "C" void kernel_launch(void* const* d_in, const int* in_sizes, int n_in, void* d_out, int out_size, void* d_ws, size_t ws_size, hipStream_t stream) {
    static int grid_blocks = 0;
    if (grid_blocks == 0) {
        if (n_in != 36 || ws_size < WS_END) { fprintf(stderr, "kernel_launch: unexpected n_in %d / ws_size %zu\n", n_in, ws_size); grid_blocks = -1; return; }
        int dev = 0, cus = 0, per_cu = 0;
        hipGetDevice(&dev);
        hipDeviceGetAttribute(&cus, hipDeviceAttributeMultiprocessorCount, dev);
        hipFuncSetAttribute((const void*)fwd_megakernel, hipFuncAttributeMaxDynamicSharedMemorySize, LDS_BYTES);
        hipOccupancyMaxActiveBlocksPerMultiprocessor(&per_cu, (const void*)fwd_megakernel, 512, LDS_BYTES);
        if (per_cu < 1) per_cu = 1;
        grid_blocks = cus * per_cu;
        (void)hipGetLastError();
    }
    if (grid_blocks < 0) return;
    Args a{};
    for (int i = 0; i < 36; ++i) a.in[i] = (const float*)d_in[i];
    a.out = (float*)d_out; a.ws = (unsigned char*)d_ws;
    void* args[] = {&a};
    hipError_t e = hipLaunchCooperativeKernel((const void*)fwd_megakernel, dim3(grid_blocks), dim3(512), args, LDS_BYTES, stream);
    if (e != hipSuccess) fprintf(stderr, "cooperative launch failed: %s (grid %d)\n", hipGetErrorString(e), grid_blocks);
}
```
